# Optimizing an MI355X kernel written in HIP

```python
import math
import jax, jax.numpy as jnp
from jax import lax
import numpy as np

D_MODEL = 2048
BATCH = 1
SEQ = 8192
DEPTH = 4

CHUNK = 64
Q_BLOCK = 128
ROPE_THETA = 500000.0
NORM_EPS = 1e-6

LRU_WIDTH = 768
LRU_BLOCKS = 6
LRU_BLOCK_W = LRU_WIDTH // LRU_BLOCKS
CONV_W = 4
LRU_C = 8.0

DIFF_HEADS = 4
DIFF_HEAD_DIM = 64
DIFF_V_DIM = 2 * DIFF_HEAD_DIM
DIFF_QK = DIFF_HEADS * 2 * DIFF_HEAD_DIM
DIFF_OUT = DIFF_HEADS * DIFF_V_DIM
DIFF_ROT = DIFF_HEAD_DIM // 4
SUBLN_EPS = 1e-5

MLA_HEADS = 6
MLA_NOPE = 128
MLA_ROPE = 64
MLA_V = 128
MLA_Q_RANK = 512
MLA_KV_RANK = 256
MLA_OUT = MLA_HEADS * MLA_V

MIX_WIDTH = LRU_WIDTH + DIFF_OUT + MLA_OUT
IN_SIZES = (LRU_WIDTH, LRU_WIDTH, DIFF_QK, DIFF_QK, DIFF_OUT, MLA_Q_RANK, MLA_KV_RANK + MLA_ROPE)
IN_WIDTH = 768 + 768 + 512 + 512 + 512 + 512 + 320
IN_SPLITS = (768, 1536, 2048, 2560, 3072, 3584)

D_FF = -(-8 * D_MODEL // (3 * 256)) * 256

kernel_name = "hybrid_rglru_diffattn_mla_block"


def rmsnorm(x, g, eps=NORM_EPS):
    xf = x.astype(jnp.float32)
    y = xf * lax.rsqrt(jnp.mean(xf * xf, axis=-1, keepdims=True) + eps)
    return (y * g.astype(jnp.float32)).astype(x.dtype)


def rope(x, positions, rot_dim):
    half = rot_dim // 2
    inv_freq = ROPE_THETA ** (-jnp.arange(half, dtype=jnp.float32) / half)
    ang = positions.astype(jnp.float32)[..., None] * inv_freq
    ang = ang.reshape(ang.shape[:2] + (1,) * (x.ndim - 3) + (half,))
    cos = jnp.cos(ang).astype(x.dtype)
    sin = jnp.sin(ang).astype(x.dtype)
    x1 = x[..., :half]
    x2 = x[..., half:rot_dim]
    return jnp.concatenate([x1 * cos - x2 * sin, x2 * cos + x1 * sin, x[..., rot_dim:]], axis=-1)


def chunk_causal_attention(q, k, v, coeff, scale):
    B, S, H, M, d = q.shape
    dv = v.shape[-1]
    n_blk = S // Q_BLOCK
    key_chunk = jnp.arange(S) // CHUNK
    kf = k.astype(jnp.float32)
    vf = v.astype(jnp.float32)
    cf = coeff.astype(jnp.float32)
    q_blocks = jnp.moveaxis(q.reshape(B, n_blk, Q_BLOCK, H, M, d), 1, 0)

    def one_block(args):
        q_blk, blk = args
        s = jnp.einsum('bqhmd,bkhmd->bhmqk', q_blk.astype(jnp.float32), kf) * scale
        q_chunk = (blk * Q_BLOCK + jnp.arange(Q_BLOCK)) // CHUNK
        mask = key_chunk[None, :] <= q_chunk[:, None]
        s = jnp.where(mask, s, -1e30)
        p = jax.nn.softmax(s, axis=-1)
        w = jnp.einsum('bhmqk,m->bhqk', p, cf)
        return jnp.einsum('bhqk,bkhd->bqhd', w, vf)

    out = lax.map(one_block, (q_blocks, jnp.arange(n_blk)))
    return jnp.moveaxis(out, 0, 1).reshape(B, S, H, dv).astype(v.dtype)


def _lru_combine(c1, c2):
    a1, b1 = c1
    a2, b2 = c2
    return a1 * a2, a2 * b1 + b2


def rglru_group(xb, yb, conv_w, conv_b, w_r, b_r, w_i, b_i, lru_lambda):
    B, S, C = xb.shape
    xc = lax.conv_general_dilated(
        xb, conv_w[:, None, :].astype(xb.dtype), window_strides=(1,),
        padding=[(CONV_W - 1, 0)], dimension_numbers=('NWC', 'WIO', 'NWC'),
        feature_group_count=C) + conv_b
    xh = xc.reshape(B, S, LRU_BLOCKS, LRU_BLOCK_W)
    r = jax.nn.sigmoid(jnp.einsum('bshc,hcd->bshd', xh, w_r).reshape(B, S, C) + b_r)
    i = jax.nn.sigmoid(jnp.einsum('bshc,hcd->bshd', xh, w_i).reshape(B, S, C) + b_i)
    log_a = -LRU_C * r.astype(jnp.float32) * jax.nn.softplus(-lru_lambda.astype(jnp.float32))
    a = jnp.exp(log_a)
    b = jnp.sqrt(-jnp.expm1(2.0 * log_a)) * (i * xc).astype(jnp.float32)
    _, h = lax.associative_scan(_lru_combine, (a, b), axis=1)
    return h.astype(xb.dtype) * jax.nn.gelu(yb)


def diff_attention_group(dq, dk, dv, positions, lam_q1, lam_k1, lam_q2, lam_k2, g_sub, lambda_init):
    B, S, _ = dq.shape
    q = rope(dq.reshape(B, S, DIFF_HEADS, 2, DIFF_HEAD_DIM), positions, DIFF_ROT)
    k = rope(dk.reshape(B, S, DIFF_HEADS, 2, DIFF_HEAD_DIM), positions, DIFF_ROT)
    v = dv.reshape(B, S, DIFF_HEADS, DIFF_V_DIM)
    lam = (jnp.exp(jnp.sum(lam_q1.astype(jnp.float32) * lam_k1.astype(jnp.float32)))
           - jnp.exp(jnp.sum(lam_q2.astype(jnp.float32) * lam_k2.astype(jnp.float32)))
           + lambda_init)
    coeff = jnp.stack([jnp.ones((), jnp.float32), -lam])
    o = chunk_causal_attention(q, k, v, coeff, DIFF_HEAD_DIM ** -0.5)
    o = rmsnorm(o, g_sub, eps=SUBLN_EPS) * (1.0 - lambda_init)
    return o.reshape(B, S, DIFF_OUT)


def mla_group(q_a, kv_a, positions, g_q_a, w_q_b, g_kv_a, w_kv_b):
    B, S, _ = q_a.shape
    q = (rmsnorm(q_a, g_q_a) @ w_q_b).reshape(B, S, MLA_HEADS, MLA_NOPE + MLA_ROPE)
    q = jnp.concatenate([q[..., :MLA_NOPE], rope(q[..., MLA_NOPE:], positions, MLA_ROPE)], axis=-1)
    kv_c = kv_a[..., :MLA_KV_RANK]
    k_rope = rope(kv_a[..., MLA_KV_RANK:], positions, MLA_ROPE)
    kv = (rmsnorm(kv_c, g_kv_a) @ w_kv_b).reshape(B, S, MLA_HEADS, MLA_NOPE + MLA_V)
    k = jnp.concatenate(
        [kv[..., :MLA_NOPE], jnp.broadcast_to(k_rope[:, :, None, :], (B, S, MLA_HEADS, MLA_ROPE))], axis=-1)
    v = kv[..., MLA_NOPE:]
    o = chunk_causal_attention(q[:, :, :, None, :], k[:, :, :, None, :], v,
                               jnp.ones((1,), jnp.float32), (MLA_NOPE + MLA_ROPE) ** -0.5)
    return o.reshape(B, S, MLA_OUT)


def setup_inputs(seed: int = 0) -> dict:
    key = jax.random.key(seed)
    ks = jax.random.split(key, 32)

    def nrm(k, shape, scale):
        return jax.random.normal(k, shape, jnp.float32) * scale

    def gain(k, shape):
        return 1.0 + 0.01 * jax.random.normal(k, shape, jnp.float32)

    x = jax.random.normal(ks[0], (BATCH, SEQ, D_MODEL), jnp.float32)
    offset = jax.random.randint(ks[1], (BATCH, 1), 0, 4096, dtype=jnp.int32)
    positions = offset + jnp.arange(SEQ, dtype=jnp.int32)[None, :]

    a0 = jax.random.uniform(ks[11], (DEPTH, LRU_WIDTH), jnp.float32, 0.9, 0.999)
    s0 = a0 ** (1.0 / LRU_C)
    lru_lambda = jnp.log(s0) - jnp.log1p(-s0)

    return {
        "x": x,
        "positions": positions,
        "g_mix": gain(ks[2], (DEPTH, D_MODEL)),
        "w_in": nrm(ks[3], (DEPTH, D_MODEL, IN_WIDTH), D_MODEL ** -0.5),
        "conv_w": nrm(ks[4], (DEPTH, CONV_W, LRU_WIDTH), CONV_W ** -0.5),
        "conv_b": nrm(ks[5], (DEPTH, LRU_WIDTH), 0.01),
        "w_r": nrm(ks[6], (DEPTH, LRU_BLOCKS, LRU_BLOCK_W, LRU_BLOCK_W), LRU_BLOCK_W ** -0.5),
        "b_r": nrm(ks[7], (DEPTH, LRU_WIDTH), 0.01),
        "w_i": nrm(ks[8], (DEPTH, LRU_BLOCKS, LRU_BLOCK_W, LRU_BLOCK_W), LRU_BLOCK_W ** -0.5),
        "b_i": nrm(ks[9], (DEPTH, LRU_WIDTH), 0.01),
        "lru_lambda": lru_lambda,
        "lam_q1": nrm(ks[12], (DEPTH, DIFF_HEAD_DIM), 0.1),
        "lam_k1": nrm(ks[13], (DEPTH, DIFF_HEAD_DIM), 0.1),
        "lam_q2": nrm(ks[14], (DEPTH, DIFF_HEAD_DIM), 0.1),
        "lam_k2": nrm(ks[15], (DEPTH, DIFF_HEAD_DIM), 0.1),
        "g_sub": gain(ks[16], (DEPTH, DIFF_V_DIM)),
        "g_q_a": gain(ks[17], (DEPTH, MLA_Q_RANK)),
        "w_q_b": nrm(ks[18], (DEPTH, MLA_Q_RANK, MLA_HEADS * (MLA_NOPE + MLA_ROPE)), MLA_Q_RANK ** -0.5),
        "g_kv_a": gain(ks[19], (DEPTH, MLA_KV_RANK)),
        "w_kv_b": nrm(ks[20], (DEPTH, MLA_KV_RANK, MLA_HEADS * (MLA_NOPE + MLA_V)), MLA_KV_RANK ** -0.5),
        "w_out": nrm(ks[21], (DEPTH, MIX_WIDTH, D_MODEL), MIX_WIDTH ** -0.5),
        "g_ffn": gain(ks[22], (DEPTH, D_MODEL)),
        "w_gate": nrm(ks[23], (DEPTH, D_MODEL, D_FF), D_MODEL ** -0.5),
        "w_up": nrm(ks[24], (DEPTH, D_MODEL, D_FF), D_MODEL ** -0.5),
        "w_down": nrm(ks[25], (DEPTH, D_FF, D_MODEL), D_FF ** -0.5),
        "g_final": gain(ks[26], (D_MODEL,)),
    }


def reference(x, positions, g_mix, w_in, conv_w, conv_b, w_r, b_r, w_i, b_i, lru_lambda,
              lam_q1, lam_k1, lam_q2, lam_k2, g_sub, g_q_a, w_q_b, g_kv_a, w_kv_b,
              w_out, g_ffn, w_gate, w_up, w_down, g_final):
    for l in range(DEPTH):
        lambda_init = 0.8 - 0.6 * math.exp(-0.3 * l)
        h = rmsnorm(x, g_mix[l])
        proj = h @ w_in[l]
        lru_x, lru_y, dq, dk, dv, q_a, kv_a = jnp.split(proj, IN_SPLITS, axis=-1)
        out_a = rglru_group(lru_x, lru_y, conv_w[l], conv_b[l], w_r[l], b_r[l], w_i[l], b_i[l], lru_lambda[l])
        out_b = diff_attention_group(dq, dk, dv, positions, lam_q1[l], lam_k1[l], lam_q2[l], lam_k2[l],
                                     g_sub[l], lambda_init)
        out_c = mla_group(q_a, kv_a, positions, g_q_a[l], w_q_b[l], g_kv_a[l], w_kv_b[l])
        mix = jnp.concatenate([out_a, out_b, out_c], axis=-1)
        x = x + mix @ w_out[l]
        h = rmsnorm(x, g_ffn[l])
        x = x + (jax.nn.silu(h @ w_gate[l]) * (h @ w_up[l])) @ w_down[l]
    return rmsnorm(x, g_final)
```

```cpp
#include <hip/hip_runtime.h>
#include <hip/hip_cooperative_groups.h>
#include <cstdio>
#include <cstdint>
namespace cg = cooperative_groups;

#define LAS __attribute__((address_space(3)))
typedef unsigned short bf16_t;
typedef short bf16x8 __attribute__((ext_vector_type(8)));
typedef short s16x4 __attribute__((ext_vector_type(4)));
typedef float f32x4 __attribute__((ext_vector_type(4)));
typedef float f32x2 __attribute__((ext_vector_type(2)));
typedef float f32x16 __attribute__((ext_vector_type(16)));
typedef unsigned u32x4 __attribute__((ext_vector_type(4)));
typedef unsigned u32x2 __attribute__((ext_vector_type(2)));

constexpr int S = 8192, DM = 2048, DEPTH = 4;
constexpr int NPROJ = 4096;
constexpr int DFF = 5632;
constexpr int NQ = 1280;
constexpr int NKV = 1536;
constexpr int NKVP = 1600;
constexpr int NGU = 2 * DFF;
constexpr float NORM_EPS = 1e-6f, SUBLN_EPS = 1e-5f;

constexpr size_t MiB = 1u << 20;
constexpr size_t WS_SSQ = 0;
constexpr size_t WS_GB = 1 * MiB;
constexpr size_t WS_TABD = 2 * MiB;
constexpr size_t WS_TABM = 3 * MiB;
constexpr size_t WS_CP = 5 * MiB, WS_CH = 6 * MiB;
constexpr size_t WS_BAR = 7 * MiB + 512 * 1024;
constexpr size_t WS_ORDER = 7 * MiB;
constexpr size_t WS_W = 8 * MiB;
constexpr size_t W_WIN = 0, W_WQB = 16 * MiB, W_WKVB = 18 * MiB, W_WG = 19 * MiB, W_WOUT = 21 * MiB, W_WGU = 29 * MiB, W_WDOWN = 73 * MiB, LAYER_W = 95 * MiB;
constexpr size_t WS_X = WS_W + 4 * LAYER_W;
constexpr size_t WS_HN = WS_X + 64 * MiB;
constexpr size_t WS_MIX = WS_HN + 32 * MiB;
constexpr size_t WS_PROJ0 = WS_MIX + 32 * MiB;
constexpr size_t PROJ_PAD = 4 * NPROJ * 2;
constexpr size_t WS_ACT = WS_PROJ0 + 1 * MiB;
constexpr size_t WS_Q = WS_PROJ0 + 65 * MiB;
constexpr size_t WS_KV = WS_Q + 20 * MiB;
constexpr size_t WS_A = WS_KV + 26 * MiB;
constexpr size_t WS_B = WS_A + 24 * MiB;
constexpr size_t WS_STASH = WS_B + 24 * MiB;
constexpr size_t WS_PARTO = WS_STASH + 16 * MiB;
constexpr size_t WS_PARTML = WS_PARTO + 56 * MiB;
constexpr size_t WS_END = WS_PARTML + 1 * MiB;
static_assert(WS_ACT + (size_t)S * DFF * 2 <= WS_A, "ACT overlay");

constexpr int LDS_BYTES = 147456;

__device__ __forceinline__ unsigned f2bf(float f) { unsigned u = __builtin_bit_cast(unsigned, f); return (u + 0x7fffu + ((u >> 16) & 1u)) >> 16; }
__device__ __forceinline__ unsigned pk2(float lo, float hi) { return f2bf(lo) | (f2bf(hi) << 16); }
__device__ __forceinline__ float bf2f(unsigned v) { return __builtin_bit_cast(float, v << 16); }
__device__ __forceinline__ unsigned cvt_pk_bf16(float lo, float hi) { unsigned r; asm volatile("v_cvt_pk_bf16_f32 %0, %1, %2" : "=v"(r) : "v"(lo), "v"(hi)); return r; }
__device__ __forceinline__ float wave_sum(float v) {
#pragma unroll
    for (int o = 1; o < 64; o <<= 1) v += __shfl_xor(v, o);
    return v;
}
__device__ __forceinline__ float fexp(float x) { return __builtin_amdgcn_exp2f(x * 1.4426950408889634f); }
__device__ __forceinline__ float sigmoidf_(float x) { return __builtin_amdgcn_rcpf(1.f + fexp(-x)); }
__device__ __forceinline__ float gelu_tanh(float y) { const float z = 0.7978845608028654f * (y + 0.044715f * y * y * y); const float t = 1.f - 2.f * __builtin_amdgcn_rcpf(fexp(2.f * z) + 1.f); return 0.5f * y * (1.f + t); }
__device__ __forceinline__ void rope4(f32x4& v0, f32x4& v1, const float* cs) {
    const f32x4 t0 = *(const f32x4*)cs, t1 = *(const f32x4*)(cs + 4);
    f32x4 a, b;
    a[0] = v0[0] * t0[0] - v0[1] * t0[1]; a[1] = v0[1] * t0[0] + v0[0] * t0[1];
    a[2] = v0[2] * t0[2] - v0[3] * t0[3]; a[3] = v0[3] * t0[2] + v0[2] * t0[3];
    b[0] = v1[0] * t1[0] - v1[1] * t1[1]; b[1] = v1[1] * t1[0] + v1[0] * t1[1];
    b[2] = v1[2] * t1[2] - v1[3] * t1[3]; b[3] = v1[3] * t1[2] + v1[2] * t1[3];
    v0 = a; v1 = b;
}

namespace pg8 {
constexpr int BM = 256, BK = 64, HALF = 128, HTB = HALF * BK * 2, STAGE_BYTES = 8 * HTB, NXCD = 8, WGM = 8;
__host__ __device__ __forceinline__ int lds_byte(int r, int c) { const int st = (r >> 4) * 2 + (c >> 5), rr = r & 15, cc = c & 31, ob = rr * 64 + cc * 2; return st * 1024 + (ob ^ (((ob >> 9) & 1) << 5)); }
__host__ __device__ __forceinline__ void stage_rc(int b, int& R, int& C) { const int st = b / 1024, sb = b % 1024, swz = sb ^ (((sb >> 9) & 1) << 5); R = (st >> 1) * 16 + swz / 64; C = (st & 1) * 32 + (swz % 64) / 2; }
__host__ __device__ __forceinline__ int perm32(int rho) { const int n = rho >> 4, i = rho & 15; return 8 * (i >> 2) + 4 * n + (i & 3); }

struct Unit { int pm, pn; };
struct Gemm { const bf16_t* A; const bf16_t* Bt; int lda, K; int a_pn_bytes; };

struct StaticOrder {
    int nM, nN, nwg, G, c;
    __device__ void init(int M, int N, int G_, int c_) { nM = M / BM; nN = N / BM; nwg = nM * nN; G = G_; c = c_; }
    __device__ bool next(int i, Unit& u) const {
        const long L = (long)i * G + c; if (L >= nwg) return false;
        int wgid = (int)L; { const int q = nwg / NXCD, r = nwg % NXCD, xcd = wgid % NXCD, off = wgid / NXCD; wgid = (xcd < r ? xcd * (q + 1) : r * (q + 1) + (xcd - r) * q) + off; }
        const int nig = WGM * nN, gid = wgid / nig, fm = gid * WGM, gsz = (nM - fm) < WGM ? (nM - fm) : WGM;
        u.pm = fm + ((wgid % nig) % gsz); u.pn = (wgid % nig) / gsz; return true;
    }
};

template <class Epi, bool CONV>
__device__ __forceinline__ void gemm_phase(LAS unsigned char* lds, const Gemm g, const StaticOrder& S_, const Epi& E) {
    int tid_ = threadIdx.x; asm volatile("" : "+v"(tid_));
    const int tid = tid_, wid = __builtin_amdgcn_readfirstlane(tid >> 6), lane = tid & 63, wr = wid >> 2, wc = wid & 3, fr = lane & 15, fq = lane >> 4;
    const int K = g.K, nt = K / BK, lda = g.lda;
    unsigned voffA[2], voffB[2];
#pragma unroll
    for (int i = 0; i < 2; ++i) { int R, C; stage_rc(tid * 16 + i * 8192, R, C); const int Rb = Epi::PERM ? ((R & ~31) + perm32(R & 31)) : R;
        voffA[i] = (unsigned)(R * lda + C) * 2u; voffB[i] = (unsigned)(Rb * K + C) * 2u; }
    const size_t kstep = (size_t)(BK * 2);
    const size_t hstepA = (size_t)HALF * lda * 2, hstepB = (size_t)HALF * K * 2;
    const size_t tstepA = 2 * hstepA, tstepB = 2 * hstepB;
    const unsigned ldsw = (unsigned)wid * 1024u;
    const int aoff = lds_byte(wr * 64 + fr, fq * 8), boff = lds_byte(wc * 32 + fr, fq * 8);
    auto akoff = [&](int t) -> long { if constexpr (CONV) return ((long)((t >> 1) - 3) * lda + (t & 1) * 64) * 2; else return (long)t * 128; };
#define PG8_SA(b, h) (((b) * 2 + (h)) * HTB)
#define PG8_SB(b, h) ((4 + (b) * 2 + (h)) * HTB)
#define PG8_STAGE(bufoff, gbase, voff) do { _Pragma("unroll") for (int _i = 0; _i < 2; ++_i) \
        __builtin_amdgcn_global_load_lds((const unsigned*)((const char*)(gbase) + (voff)[_i]), (LAS unsigned*)(lds + (bufoff) + ldsw + _i * 8192), 16, 0, 0); } while (0)
#define PG8_LDA(dst, b, h) do { _Pragma("unroll") for (int m = 0; m < 4; ++m) _Pragma("unroll") for (int k = 0; k < 2; ++k) dst[m][k] = *(const LAS bf16x8*)(lds + PG8_SA(b, h) + aoff + m * 2048 + k * 1024); } while (0)
#define PG8_LDB(dst, b, h) do { _Pragma("unroll") for (int n = 0; n < 2; ++n) _Pragma("unroll") for (int k = 0; k < 2; ++k) dst[n][k] = *(const LAS bf16x8*)(lds + PG8_SB(b, h) + boff + n * 2048 + k * 1024); } while (0)
#define PG8_MMA(ai, bj, At, Bt) do { __builtin_amdgcn_s_setprio(1); _Pragma("unroll") for (int m = 0; m < 4; ++m) _Pragma("unroll") for (int n = 0; n < 2; ++n) _Pragma("unroll") for (int k = 0; k < 2; ++k) \
        acc[ai][bj][m][n] = __builtin_amdgcn_mfma_f32_16x16x32_bf16(Bt[n][k], At[m][k], acc[ai][bj][m][n], 0, 0, 0); __builtin_amdgcn_s_setprio(0); } while (0)
#define PG8_WAIT_V(n) asm volatile("s_waitcnt vmcnt(" #n ")" ::: "memory")
#define PG8_WAIT_L(n) asm volatile("s_waitcnt lgkmcnt(" #n ")" ::: "memory")
#define PG8_BAR __builtin_amdgcn_s_barrier()
#define PG8_SCHED __builtin_amdgcn_sched_barrier(0)
    Unit cur, nxt; int ui = 0;
    if (!S_.next(0, cur)) return;
    f32x4 acc[2][2][4][2];
#pragma unroll
    for (int a = 0; a < 2; ++a)
#pragma unroll
        for (int b = 0; b < 2; ++b)
#pragma unroll
            for (int m = 0; m < 4; ++m)
#pragma unroll
                for (int n = 0; n < 2; ++n) acc[a][b][m][n] = (f32x4){0.f, 0.f, 0.f, 0.f};
    bf16x8 At[4][2], B0[2][2], B1[2][2];
    const char* cA = (const char*)g.A + (size_t)cur.pm * tstepA + (size_t)cur.pn * g.a_pn_bytes; const char* cB = (const char*)g.Bt + (size_t)cur.pn * tstepB;
    {
        const char* a0 = cA + akoff(0); const char* a1p = cA + akoff(1);
        PG8_STAGE(PG8_SB(0, 0), cB, voffB); PG8_STAGE(PG8_SB(0, 1), cB + hstepB, voffB); PG8_STAGE(PG8_SA(0, 0), a0, voffA); PG8_STAGE(PG8_SA(0, 1), a0 + hstepA, voffA);
        if (wr == 1) PG8_BAR;
        PG8_WAIT_V(2); PG8_BAR;
        PG8_STAGE(PG8_SB(1, 0), cB + kstep, voffB); PG8_STAGE(PG8_SA(1, 0), a1p, voffA); PG8_STAGE(PG8_SB(1, 1), cB + hstepB + kstep, voffB);
        PG8_WAIT_V(6); PG8_BAR;
    }
    for (;;) {
        const bool has_next = S_.next(ui + 1, nxt);
        const char* nA = has_next ? (const char*)g.A + (size_t)nxt.pm * tstepA + (size_t)nxt.pn * g.a_pn_bytes : cA; const char* nB = has_next ? (const char*)g.Bt + (size_t)nxt.pn * tstepB : cB;
        for (int t = 0; t < nt; t += 2) {
            const bool last = (t == nt - 2);
            const char* a1 = cA + akoff(t + 1);
            const char* a2 = last ? nA + akoff(0) : cA + akoff(t + 2); const char* b2 = last ? nB : cB + (size_t)(t + 2) * kstep;
            const char* a3 = last ? nA + akoff(1) : cA + akoff(t + 3); const char* b3 = b2 + kstep;
            PG8_LDB(B0, 0, 0); PG8_LDB(B1, 0, 1); PG8_SCHED; PG8_LDA(At, 0, 0); PG8_STAGE(PG8_SA(1, 1), a1 + hstepA, voffA);
            PG8_WAIT_V(8); PG8_WAIT_L(0); PG8_BAR; PG8_MMA(0, 0, At, B0); PG8_MMA(0, 1, At, B1); PG8_BAR; PG8_SCHED;
            PG8_LDA(At, 0, 1); PG8_STAGE(PG8_SB(0, 0), b2, voffB); PG8_STAGE(PG8_SB(0, 1), b2 + hstepB, voffB); PG8_STAGE(PG8_SA(0, 0), a2, voffA);
            PG8_WAIT_V(8); PG8_WAIT_L(0); PG8_BAR; PG8_MMA(1, 0, At, B0); PG8_MMA(1, 1, At, B1); PG8_BAR; PG8_SCHED;
            PG8_LDB(B0, 1, 0); PG8_LDB(B1, 1, 1); PG8_SCHED; PG8_LDA(At, 1, 0); PG8_STAGE(PG8_SA(0, 1), a2 + hstepA, voffA);
            PG8_WAIT_V(8); PG8_WAIT_L(0); PG8_BAR; PG8_MMA(0, 0, At, B0); PG8_MMA(0, 1, At, B1); PG8_BAR; PG8_SCHED;
            PG8_LDA(At, 1, 1); PG8_STAGE(PG8_SB(1, 0), b3, voffB); PG8_STAGE(PG8_SB(1, 1), b3 + hstepB, voffB); PG8_STAGE(PG8_SA(1, 0), a3, voffA);
            PG8_WAIT_V(8); PG8_WAIT_L(0); PG8_BAR; PG8_MMA(1, 0, At, B0); PG8_MMA(1, 1, At, B1); PG8_BAR; PG8_SCHED;
        }
        if (wr == 0) PG8_BAR;
        E(acc, cur, wr, wc, fr, fq);
        if (!has_next) break;
#pragma unroll
        for (int a = 0; a < 2; ++a)
#pragma unroll
            for (int b = 0; b < 2; ++b)
#pragma unroll
                for (int m = 0; m < 4; ++m)
#pragma unroll
                    for (int n = 0; n < 2; ++n) acc[a][b][m][n] = (f32x4){0.f, 0.f, 0.f, 0.f};
        cur = nxt; cA = nA; cB = nB; ++ui;
        if (wr == 1) PG8_BAR;
    }
    PG8_WAIT_V(0);
    PG8_BAR;
#undef PG8_SA
#undef PG8_SB
#undef PG8_STAGE
#undef PG8_LDA
#undef PG8_LDB
#undef PG8_MMA
#undef PG8_WAIT_V
#undef PG8_WAIT_L
#undef PG8_BAR
#undef PG8_SCHED
}
}

typedef const f32x4 (&AccT)[2][2][4][2];

struct EpiProj {
    static constexpr bool PERM = true;
    bf16_t* O; const float* tabd; const float* tabm; float* ssqp; bf16_t* KV;
    __device__ __forceinline__ void operator()(AccT acc, const pg8::Unit& u, int wr, int wc, int fr, int fq) const {
        const int row0 = u.pm * 256 + wr * 64 + fr, col0 = u.pn * 256 + wc * 32 + 8 * fq, pn = u.pn;
        const bool ropeD = (pn >= 6 && pn < 10) && ((wc & 1) == 0) && (fq < 2);
        const bool ropeM = (pn == 15) && (wc < 2);
        const int slot = (pn == 12 || pn == 13) ? (pn - 12) * 4 + wc : (pn == 14 ? 8 + wc : -1);
#pragma unroll
        for (int ai = 0; ai < 2; ++ai)
#pragma unroll
            for (int m = 0; m < 4; ++m) {
                const int row = row0 + ai * 128 + m * 16; bf16_t* rowp = O + (size_t)row * NPROJ + col0; float ss = 0.f;
#pragma unroll
                for (int bj = 0; bj < 2; ++bj) {
                    f32x4 v0 = acc[ai][bj][m][0], v1 = acc[ai][bj][m][1];
                    if (ropeD) rope4(v0, v1, tabd + (size_t)row * 16 + 8 * fq);
                    if (ropeM && bj == 0) rope4(v0, v1, tabm + (size_t)row * 64 + (16 * wc + 4 * fq) * 2);
                    ss += (v0[0] * v0[0] + v0[1] * v0[1]) + (v0[2] * v0[2] + v0[3] * v0[3]) + (v1[0] * v1[0] + v1[1] * v1[1]) + (v1[2] * v1[2] + v1[3] * v1[3]);
                    u32x4 w; w.x = cvt_pk_bf16(v0[0], v0[1]); w.y = cvt_pk_bf16(v0[2], v0[3]); w.z = cvt_pk_bf16(v1[0], v1[1]); w.w = cvt_pk_bf16(v1[2], v1[3]);
                    *(u32x4*)(rowp + bj * 128) = w;
                    if (ropeM && bj == 0) *(u32x4*)(KV + (size_t)row * NKVP + 1536 + wc * 32 + 8 * fq) = w;
                }
                if (slot >= 0) { ss += __shfl_xor(ss, 16); ss += __shfl_xor(ss, 32); if (fq == 0) ssqp[(size_t)row * 16 + slot] = ss; }
            }
    }
};
struct EpiScaleRope {
    static constexpr bool PERM = true;
    bf16_t* O; int ldc; const float* ssqp; int nparts4; float inv_n; const float* tabm; int rope_tile0;
    __device__ __forceinline__ void operator()(AccT acc, const pg8::Unit& u, int wr, int wc, int fr, int fq) const {
        const int row0 = u.pm * 256 + wr * 64 + fr, col0 = u.pn * 256 + wc * 32 + 8 * fq;
        const bool rp = u.pn >= rope_tile0;
#pragma unroll
        for (int ai = 0; ai < 2; ++ai)
#pragma unroll
            for (int m = 0; m < 4; ++m) {
                const int row = row0 + ai * 128 + m * 16; bf16_t* rowp = O + (size_t)row * ldc + col0;
                float sq; { const f32x4 a = *(const f32x4*)(ssqp + (size_t)row * 16); sq = (a[0] + a[1]) + (a[2] + a[3]); if (nparts4 > 1) { const f32x4 b = *(const f32x4*)(ssqp + (size_t)row * 16 + 4); sq += (b[0] + b[1]) + (b[2] + b[3]); } }
                const float rs = 1.f / sqrtf(sq * inv_n + NORM_EPS);
#pragma unroll
                for (int bj = 0; bj < 2; ++bj) {
                    f32x4 v0 = acc[ai][bj][m][0] * rs, v1 = acc[ai][bj][m][1] * rs;
                    if (rp) rope4(v0, v1, tabm + (size_t)row * 64 + (16 * (wc & 1) + 4 * fq) * 2);
                    u32x4 w; w.x = cvt_pk_bf16(v0[0], v0[1]); w.y = cvt_pk_bf16(v0[2], v0[3]); w.z = cvt_pk_bf16(v1[0], v1[1]); w.w = cvt_pk_bf16(v1[2], v1[3]);
                    *(u32x4*)(rowp + bj * 128) = w;
                }
            }
    }
};
struct EpiGate {
    static constexpr bool PERM = true;
    const bf16_t* PROJ; const float* conv_w; const float* conv_b; const float* gbr; const float* gbi; const float* spl; float* Aout; float* Bout;
    __device__ __forceinline__ void operator()(AccT acc, const pg8::Unit& u, int wr, int wc, int fr, int fq) const {
        const int row0 = u.pm * 256 + wr * 64 + fr;
#pragma unroll
        for (int n = 0; n < 2; ++n) {
            const int cb = u.pn * 128 + wc * 32 + 8 * fq + 4 * n;
            const f32x4 cw0 = *(const f32x4*)(conv_w + cb), cw1 = *(const f32x4*)(conv_w + 768 + cb), cw2 = *(const f32x4*)(conv_w + 1536 + cb), cw3 = *(const f32x4*)(conv_w + 2304 + cb);
            const f32x4 cbias = *(const f32x4*)(conv_b + cb), br = *(const f32x4*)(gbr + cb), bi = *(const f32x4*)(gbi + cb), sp = *(const f32x4*)(spl + cb);
#pragma unroll
            for (int ai = 0; ai < 2; ++ai)
#pragma unroll
                for (int m = 0; m < 4; ++m) {
                    const int row = row0 + ai * 128 + m * 16;
                    const bf16_t* xp = PROJ + (ptrdiff_t)(row - 3) * NPROJ + cb;
                    const u32x2 x0 = *(const u32x2*)xp, x1 = *(const u32x2*)(xp + NPROJ), x2 = *(const u32x2*)(xp + 2 * NPROJ), x3 = *(const u32x2*)(xp + 3 * NPROJ);
                    const f32x4 rr = acc[ai][0][m][n] + br, ii = acc[ai][1][m][n] + bi;
                    f32x4 av, bv;
#pragma unroll
                    for (int j = 0; j < 4; ++j) {
                        const unsigned w0 = (j < 2 ? x0.x : x0.y), w1 = (j < 2 ? x1.x : x1.y), w2 = (j < 2 ? x2.x : x2.y), w3 = (j < 2 ? x3.x : x3.y);
                        const int sh = (j & 1) ? 16 : 0;
                        const float f0 = bf2f((w0 >> sh) & 0xffffu), f1 = bf2f((w1 >> sh) & 0xffffu), f2 = bf2f((w2 >> sh) & 0xffffu), f3 = bf2f((w3 >> sh) & 0xffffu);
                        const float xc = cbias[j] + cw0[j] * f0 + cw1[j] * f1 + cw2[j] * f2 + cw3[j] * f3;
                        const float r = sigmoidf_(rr[j]), ig = sigmoidf_(ii[j]);
                        const float a = fexp(-sp[j] * r);
                        av[j] = a; bv[j] = sqrtf(fmaxf(1.f - a * a, 0.f)) * ig * xc;
                    }
                    *(f32x4*)(Aout + (size_t)row * 768 + cb) = av; *(f32x4*)(Bout + (size_t)row * 768 + cb) = bv;
                }
        }
    }
};
struct EpiResid {
    static constexpr bool PERM = false;
    const float* Xin; float* Xout;
    __device__ __forceinline__ void operator()(AccT acc, const pg8::Unit& u, int wr, int wc, int fr, int fq) const {
        const int row0 = u.pm * 256 + wr * 64 + fr, col0 = u.pn * 256 + wc * 32 + 4 * fq;
#pragma unroll
        for (int ai = 0; ai < 2; ++ai)
#pragma unroll
            for (int m = 0; m < 4; ++m) { const size_t off = (size_t)(row0 + ai * 128 + m * 16) * DM + col0;
#pragma unroll
                for (int bj = 0; bj < 2; ++bj)
#pragma unroll
                    for (int n = 0; n < 2; ++n) { const f32x4 b = *(const f32x4*)(Xin + off + bj * 128 + n * 16); *(f32x4*)(Xout + off + bj * 128 + n * 16) = b + acc[ai][bj][m][n]; } }
    }
};
struct EpiSwiGLU {
    static constexpr bool PERM = true;
    bf16_t* O;
    __device__ __forceinline__ void operator()(AccT acc, const pg8::Unit& u, int wr, int wc, int fr, int fq) const {
        const int row0 = u.pm * 256 + wr * 64 + fr, col0 = u.pn * 128 + wc * 32 + 8 * fq;
#pragma unroll
        for (int ai = 0; ai < 2; ++ai)
#pragma unroll
            for (int m = 0; m < 4; ++m) {
                bf16_t* rowp = O + (size_t)(row0 + ai * 128 + m * 16) * DFF + col0;
                f32x4 o0, o1;
#pragma unroll
                for (int j = 0; j < 4; ++j) { const float g0 = acc[ai][0][m][0][j], g1 = acc[ai][0][m][1][j];
                    o0[j] = g0 * sigmoidf_(g0) * acc[ai][1][m][0][j]; o1[j] = g1 * sigmoidf_(g1) * acc[ai][1][m][1][j]; }
                u32x4 w; w.x = cvt_pk_bf16(o0[0], o0[1]); w.y = cvt_pk_bf16(o0[2], o0[3]); w.z = cvt_pk_bf16(o1[0], o1[1]); w.w = cvt_pk_bf16(o1[2], o1[3]);
                *(u32x4*)rowp = w;
            }
    }
};

template <int D1, int D2>
__device__ __forceinline__ void attn_run(LAS unsigned char* lds, const bf16_t* Q1, int ldq1, const bf16_t* Q2, int ldq2, const bf16_t* K1, const bf16_t* K2, const bf16_t* V, int ldkv,
                                         int q0, int kt0, int kt1, float c, f32x16 (&O)[4], float& mrun, float& lsum) {
    constexpr int DQK = D1 + D2, NS = DQK / 16, KP = DQK * 2 + 16, VP = 320, KBY = 64 * KP, VBY = 64 * VP, SB = KBY + VBY, KCH = KP / 16, VCH = VP / 16, T = KCH + VCH, NDMAX = (T + 7) / 8;
    static_assert(KBY % 1024 == 0 && 3 * SB <= 139264, "attention LDS ring");
    int tid_ = threadIdx.x; asm volatile("" : "+v"(tid_));
    const int tid = tid_, lane = tid & 63, w = __builtin_amdgcn_readfirstlane(tid >> 6), r = lane & 31, h = lane >> 5;
    bf16x8 qf[NS];
    { const size_t qrow = (size_t)(q0 + 32 * w + r);
#pragma unroll
      for (int s = 0; s < NS; ++s) { if (16 * s < D1) qf[s] = *(const bf16x8*)(Q1 + qrow * ldq1 + 16 * s + 8 * h); else qf[s] = *(const bf16x8*)(Q2 + qrow * ldq2 + (16 * s - D1) + 8 * h); } }
    const int nd = (T - w + 7) / 8;
    const char* dp[NDMAX];
#pragma unroll
    for (int i = 0; i < NDMAX; ++i) {
        const int j = w + 8 * i; const bf16_t* src;
        if (j < KCH) { const int q = 64 * j + lane, row = q / KCH, cc = q % KCH; const int ce = (cc == KCH - 1) ? 0 : cc * 8;
            src = (ce < D1) ? K1 + (size_t)(64 * kt0 + row) * ldkv + ce : K2 + (size_t)(64 * kt0 + row) * ldkv + (ce - D1); }
        else { const int q = 64 * (j - KCH) + lane, row = q / VCH, cc = q % VCH; src = V + (size_t)(64 * kt0 + row) * ldkv + ((cc < 16) ? cc * 8 : 0); }
        dp[i] = (const char*)src;
    }
    const size_t tstep = (size_t)64 * ldkv * 2;
#define ATT_ISSUE(stage) do { _Pragma("unroll") for (int i_ = 0; i_ < NDMAX; ++i_) if (i_ < nd) { \
        __builtin_amdgcn_global_load_lds((const unsigned*)dp[i_], (LAS unsigned*)(lds + (stage) * SB + (w + 8 * i_) * 1024), 16, 0, 0); dp[i_] += tstep; } } while (0)
#define ATT_WAIT(keep_one) do { if (keep_one) { if (nd == NDMAX) asm volatile("s_waitcnt vmcnt(%0)" :: "n"(NDMAX) : "memory"); else asm volatile("s_waitcnt vmcnt(%0)" :: "n"(NDMAX - 1) : "memory"); } \
        else asm volatile("s_waitcnt vmcnt(0)" ::: "memory"); } while (0)
    const int n = kt1 - kt0;
    asm volatile("s_waitcnt vmcnt(0) lgkmcnt(0)" ::: "memory");
    __builtin_amdgcn_s_barrier();
    asm volatile("" ::: "memory");
    ATT_ISSUE(0);
    if (n > 1) ATT_ISSUE(1);
    ATT_WAIT(n > 1);
    __builtin_amdgcn_s_barrier();
    asm volatile("" ::: "memory");
    const int mylast = (q0 >> 6) + (w >> 1);
    float l = 0.f; mrun = -1e30f;
#pragma unroll
    for (int d = 0; d < 4; ++d)
#pragma unroll
        for (int i = 0; i < 16; ++i) O[d][i] = 0.f;
    const int g4 = lane >> 4, li = lane & 15;
    const int vb = KBY + (4 * h + (li >> 2)) * VP + (16 * (g4 & 1) + 4 * (li & 3)) * 2;
    const int kb0 = r * KP + 16 * h;
    const unsigned lds_base = (unsigned)(size_t)lds;
    int stg = 0;
    for (int it = 0; it < n; ++it) {
        const bool ahead = (it + 2 < n);
        if (ahead) { const int s2 = (stg >= 1) ? stg - 1 : 2; ATT_ISSUE(s2); }
        if (kt0 + it <= mylast) {
            const unsigned ka = lds_base + stg * SB + kb0, va = lds_base + stg * SB + vb;
            f32x16 st[2];
#pragma unroll
            for (int kb = 0; kb < 2; ++kb)
#pragma unroll
                for (int i = 0; i < 16; ++i) st[kb][i] = 0.f;
            {
                constexpr int NB = (2 * NS) / 4;
                bf16x8 fa[2][4];
#define K_OFF(idx) (32 * ((idx) / NS) * KP + 32 * ((idx) % NS))
#pragma unroll
                for (int i = 0; i < 4; ++i) asm volatile("ds_read_b128 %0, %1 offset:%2" : "=&v"(fa[0][i]) : "v"(ka), "i"(K_OFF(i)) : "memory");
#pragma unroll
                for (int b = 0; b < NB; ++b) {
                    if (b + 1 < NB) {
#pragma unroll
                        for (int i = 0; i < 4; ++i) asm volatile("ds_read_b128 %0, %1 offset:%2" : "=&v"(fa[(b + 1) & 1][i]) : "v"(ka), "i"(K_OFF(4 * (b + 1) + i)) : "memory");
                        asm volatile("s_waitcnt lgkmcnt(4)" : "+v"(fa[b & 1][0]), "+v"(fa[b & 1][1]), "+v"(fa[b & 1][2]), "+v"(fa[b & 1][3]) :: "memory");
                    } else asm volatile("s_waitcnt lgkmcnt(0)" : "+v"(fa[b & 1][0]), "+v"(fa[b & 1][1]), "+v"(fa[b & 1][2]), "+v"(fa[b & 1][3]) :: "memory");
#pragma unroll
                    for (int i = 0; i < 4; ++i) { constexpr int dummy = 0; (void)dummy; const int idx = 4 * b + i; st[idx / NS] = __builtin_amdgcn_mfma_f32_32x32x16_bf16(fa[b & 1][i], qf[idx % NS], st[idx / NS], 0, 0, 0); }
                }
#undef K_OFF
            }
            float mx = fmaxf(fmaxf(st[0][0], st[0][1]), fmaxf(st[1][0], st[1][1]));
#pragma unroll
            for (int i = 2; i < 16; i += 2) mx = fmaxf(mx, fmaxf(fmaxf(st[0][i], st[0][i + 1]), fmaxf(st[1][i], st[1][i + 1])));
            mx = fmaxf(mx, __shfl_xor(mx, 32));
            const float mnew = fmaxf(mrun, mx), alpha = __builtin_amdgcn_exp2f((mrun - mnew) * c), mc = mnew * c; mrun = mnew;
            float ps = 0.f;
#pragma unroll
            for (int kb = 0; kb < 2; ++kb)
#pragma unroll
                for (int i = 0; i < 16; ++i) { const float p = __builtin_amdgcn_exp2f(st[kb][i] * c - mc); st[kb][i] = p; ps += p; }
            l = l * alpha + ps;
#pragma unroll
            for (int d = 0; d < 4; ++d) O[d] = O[d] * alpha;
            bf16x8 pf[2][2];
#pragma unroll
            for (int kb = 0; kb < 2; ++kb)
#pragma unroll
                for (int sp = 0; sp < 2; ++sp) { u32x4 t; t.x = cvt_pk_bf16(st[kb][8 * sp + 0], st[kb][8 * sp + 1]); t.y = cvt_pk_bf16(st[kb][8 * sp + 2], st[kb][8 * sp + 3]);
                    t.z = cvt_pk_bf16(st[kb][8 * sp + 4], st[kb][8 * sp + 5]); t.w = cvt_pk_bf16(st[kb][8 * sp + 6], st[kb][8 * sp + 7]); pf[kb][sp] = __builtin_bit_cast(bf16x8, t); }
            {
                s16x4 vl[2][4], vh[2][4];
#define V_OFF(d, f) ((32 * ((f) >> 1) + 16 * ((f) & 1)) * VP + 64 * (d))
#pragma unroll
                for (int f = 0; f < 4; ++f) { asm volatile("ds_read_b64_tr_b16 %0, %1 offset:%2" : "=&v"(vl[0][f]) : "v"(va), "i"(V_OFF(0, f)) : "memory");
                                              asm volatile("ds_read_b64_tr_b16 %0, %1 offset:%2" : "=&v"(vh[0][f]) : "v"(va), "i"(V_OFF(0, f) + 8 * VP) : "memory"); }
#pragma unroll
                for (int d = 0; d < 4; ++d) {
                    if (d + 1 < 4) {
#pragma unroll
                        for (int f = 0; f < 4; ++f) { asm volatile("ds_read_b64_tr_b16 %0, %1 offset:%2" : "=&v"(vl[(d + 1) & 1][f]) : "v"(va), "i"(V_OFF(d + 1, f)) : "memory");
                                                      asm volatile("ds_read_b64_tr_b16 %0, %1 offset:%2" : "=&v"(vh[(d + 1) & 1][f]) : "v"(va), "i"(V_OFF(d + 1, f) + 8 * VP) : "memory"); }
                        asm volatile("s_waitcnt lgkmcnt(8)" : "+v"(vl[d & 1][0]), "+v"(vl[d & 1][1]), "+v"(vl[d & 1][2]), "+v"(vl[d & 1][3]), "+v"(vh[d & 1][0]), "+v"(vh[d & 1][1]), "+v"(vh[d & 1][2]), "+v"(vh[d & 1][3]) :: "memory");
                    } else asm volatile("s_waitcnt lgkmcnt(0)" : "+v"(vl[d & 1][0]), "+v"(vl[d & 1][1]), "+v"(vl[d & 1][2]), "+v"(vl[d & 1][3]), "+v"(vh[d & 1][0]), "+v"(vh[d & 1][1]), "+v"(vh[d & 1][2]), "+v"(vh[d & 1][3]) :: "memory");
#pragma unroll
                    for (int f = 0; f < 4; ++f) { const s16x4 lo = vl[d & 1][f], hi = vh[d & 1][f];
                        const bf16x8 vf = (bf16x8){lo[0], lo[1], lo[2], lo[3], hi[0], hi[1], hi[2], hi[3]};
                        O[d] = __builtin_amdgcn_mfma_f32_32x32x16_bf16(vf, pf[f >> 1][f & 1], O[d], 0, 0, 0); }
                }
#undef V_OFF
            }
        }
        ATT_WAIT(ahead);
        __builtin_amdgcn_s_barrier();
        asm volatile("" ::: "memory");
        stg = (stg == 2) ? 0 : stg + 1;
    }
#undef ATT_ISSUE
#undef ATT_WAIT
    lsum = l + __shfl_xor(l, 32);
}

struct AttnArgs { const bf16_t* PROJ; const bf16_t* Qb; const bf16_t* KVb; bf16_t* MIX; float* stash; float* part_o; float* part_ml; const float* g_sub; float lam; float one_m_linit; };
constexpr float C_DIFF = 0.125f * 1.4426950408889634f, C_MLA = 0.07216878364870322f * 1.4426950408889634f;

__device__ __forceinline__ void attn_store_part(const AttnArgs& a, int pi, size_t qrow, int h, const f32x16 (&O)[4], float mrun, float lsum) {
    float* po = a.part_o + ((size_t)pi * 4096 + (qrow - 4096)) * 128;
#pragma unroll
    for (int d = 0; d < 4; ++d)
#pragma unroll
        for (int g = 0; g < 4; ++g) { f32x4 v = {O[d][4 * g], O[d][4 * g + 1], O[d][4 * g + 2], O[d][4 * g + 3]}; *(f32x4*)(po + 32 * d + 8 * g + 4 * h) = v; }
    if (h == 0) { f32x2 ml = {mrun, lsum}; *(f32x2*)(a.part_ml + ((size_t)pi * 4096 + (qrow - 4096)) * 2) = ml; }
}
__device__ __forceinline__ void attn_unit_diff_part(LAS unsigned char* lds, const AttnArgs& a, int hd, int map, int qb, int part) {
    int tid_ = threadIdx.x; asm volatile("" : "+v"(tid_));
    const int tid = tid_, lane = tid & 63, w = tid >> 6, r = lane & 31, h = lane >> 5;
    const int q0 = 256 * qb, nt = 4 * qb + 4, kt0 = part ? nt / 2 : 0, kt1 = part ? nt : nt / 2; const size_t qrow = (size_t)(q0 + 32 * w + r);
    f32x16 O[4]; float mrun, lsum;
    attn_run<64, 0>(lds, a.PROJ + 1536 + 128 * hd + 64 * map, NPROJ, nullptr, 0, a.PROJ + 2048 + 128 * hd + 64 * map, nullptr, a.PROJ + 2560 + 128 * hd, NPROJ, q0, kt0, kt1, C_DIFF, O, mrun, lsum);
    attn_store_part(a, (hd * 2 + map) * 2 + part, qrow, h, O, mrun, lsum);
}
__device__ __forceinline__ void attn_unit_mla_part(LAS unsigned char* lds, const AttnArgs& a, int hh, int qb, int part) {
    int tid_ = threadIdx.x; asm volatile("" : "+v"(tid_));
    const int tid = tid_, lane = tid & 63, w = tid >> 6, r = lane & 31, h = lane >> 5;
    const int q0 = 256 * qb, nt = 4 * qb + 4, kt0 = part ? nt / 2 : 0, kt1 = part ? nt : nt / 2; const size_t qrow = (size_t)(q0 + 32 * w + r);
    f32x16 O[4]; float mrun, lsum;
    attn_run<128, 64>(lds, a.Qb + 128 * hh, NQ, a.Qb + 768 + 64 * hh, NQ, a.KVb + 128 * hh, a.KVb + 1536, a.KVb + 768 + 128 * hh, NKVP, q0, kt0, kt1, C_MLA, O, mrun, lsum);
    attn_store_part(a, (8 + hh) * 2 + part, qrow, h, O, mrun, lsum);
}
__device__ __forceinline__ void attn_unit_diff(LAS unsigned char* lds, const AttnArgs& a, int hd, int qb) {
    int tid_ = threadIdx.x; asm volatile("" : "+v"(tid_));
    const int tid = tid_, lane = tid & 63, w = tid >> 6, r = lane & 31, h = lane >> 5;
    const int q0 = 256 * qb, nt = 4 * qb + 4; const size_t qrow = (size_t)(q0 + 32 * w + r);
    f32x16 O[4]; float mrun, lsum;
    float* st = a.stash + ((size_t)hd * S + qrow) * 128;
    const bf16_t* Vp = a.PROJ + 2560 + 128 * hd;
    attn_run<64, 0>(lds, a.PROJ + 1536 + 128 * hd, NPROJ, nullptr, 0, a.PROJ + 2048 + 128 * hd, nullptr, Vp, NPROJ, q0, 0, nt, C_DIFF, O, mrun, lsum);
    { const float linv = 1.f / lsum;
#pragma unroll
      for (int d = 0; d < 4; ++d)
#pragma unroll
        for (int g = 0; g < 4; ++g) { f32x4 v = {O[d][4 * g] * linv, O[d][4 * g + 1] * linv, O[d][4 * g + 2] * linv, O[d][4 * g + 3] * linv}; *(f32x4*)(st + 32 * d + 8 * g + 4 * h) = v; } }
    attn_run<64, 0>(lds, a.PROJ + 1536 + 128 * hd + 64, NPROJ, nullptr, 0, a.PROJ + 2048 + 128 * hd + 64, nullptr, Vp, NPROJ, q0, 0, nt, C_DIFF, O, mrun, lsum);
    float ss = 0.f; const float ll = a.lam / lsum;
#pragma unroll
    for (int d = 0; d < 4; ++d)
#pragma unroll
        for (int g = 0; g < 4; ++g) { const f32x4 s1 = *(const f32x4*)(st + 32 * d + 8 * g + 4 * h);
#pragma unroll
            for (int j = 0; j < 4; ++j) { const float o = s1[j] - ll * O[d][4 * g + j]; O[d][4 * g + j] = o; ss += o * o; } }
    ss += __shfl_xor(ss, 32);
    const float rs = a.one_m_linit / sqrtf(ss * (1.f / 128.f) + SUBLN_EPS);
    bf16_t* op = a.MIX + qrow * DM + 768 + 128 * hd;
#pragma unroll
    for (int d = 0; d < 4; ++d)
#pragma unroll
        for (int g = 0; g < 4; ++g) { const int dv = 32 * d + 8 * g + 4 * h; const f32x4 gs = *(const f32x4*)(a.g_sub + dv);
            u32x2 o; o.x = cvt_pk_bf16(O[d][4 * g] * rs * gs[0], O[d][4 * g + 1] * rs * gs[1]); o.y = cvt_pk_bf16(O[d][4 * g + 2] * rs * gs[2], O[d][4 * g + 3] * rs * gs[3]);
            *(u32x2*)(op + dv) = o; }
}
__device__ __forceinline__ void attn_unit_mla(LAS unsigned char* lds, const AttnArgs& a, int hh, int qb) {
    int tid_ = threadIdx.x; asm volatile("" : "+v"(tid_));
    const int tid = tid_, lane = tid & 63, w = tid >> 6, r = lane & 31, h = lane >> 5;
    const int q0 = 256 * qb, nt = 4 * qb + 4; const size_t qrow = (size_t)(q0 + 32 * w + r);
    f32x16 O[4]; float mrun, lsum;
    attn_run<128, 64>(lds, a.Qb + 128 * hh, NQ, a.Qb + 768 + 64 * hh, NQ, a.KVb + 128 * hh, a.KVb + 1536, a.KVb + 768 + 128 * hh, NKVP, q0, 0, nt, C_MLA, O, mrun, lsum);
    const float linv = 1.f / lsum;
    bf16_t* op = a.MIX + qrow * DM + 1280 + 128 * hh;
#pragma unroll
    for (int d = 0; d < 4; ++d)
#pragma unroll
        for (int g = 0; g < 4; ++g) { const int dv = 32 * d + 8 * g + 4 * h;
            u32x2 o; o.x = cvt_pk_bf16(O[d][4 * g] * linv, O[d][4 * g + 1] * linv); o.y = cvt_pk_bf16(O[d][4 * g + 2] * linv, O[d][4 * g + 3] * linv);
            *(u32x2*)(op + dv) = o; }
}
constexpr int N_ATT_UNITS = 608, SCHED_SLOTS = 5;
__device__ __forceinline__ void attn_dispatch(LAS unsigned char* lds, const AttnArgs& a, int u) {
    if (u < 64) attn_unit_diff(lds, a, u & 3, u >> 2);
    else if (u < 160) { const int v = u - 64; attn_unit_mla(lds, a, v % 6, v / 6); }
    else if (u < 416) { const int v = u - 160; attn_unit_diff_part(lds, a, (v >> 2) & 3, (v >> 1) & 1, 16 + (v >> 4), v & 1); }
    else { const int v = u - 416; attn_unit_mla_part(lds, a, (v >> 1) % 6, 16 + (v >> 1) / 6, v & 1); }
}

template <class F>
__device__ __forceinline__ void conv_mat(const F f, bf16_t* WT, int N, int K, LAS float* scr, int gw, int NGW, int lane) {
    const int nblk = N / 32, nitems = (K / 64) * nblk;
    for (int it = gw; it < nitems; it += NGW) {
        const int kb = it / nblk, nb = it % nblk, k0 = 64 * kb, n0 = 32 * nb;
        float v[32];
#pragma unroll
        for (int i = 0; i < 32; ++i) v[i] = f(k0 + 2 * i + (lane >> 5), n0 + (lane & 31));
#pragma unroll
        for (int i = 0; i < 32; ++i) scr[(2 * i + (lane >> 5)) * 33 + (lane & 31)] = v[i];
        asm volatile("s_waitcnt lgkmcnt(0)" ::: "memory");
        const int c = lane & 7;
#pragma unroll
        for (int j = 0; j < 4; ++j) { const int n = (lane >> 3) + 8 * j; const LAS float* s = scr + (8 * c) * 33 + n;
            u32x4 o; o.x = pk2(s[0 * 33], s[1 * 33]); o.y = pk2(s[2 * 33], s[3 * 33]); o.z = pk2(s[4 * 33], s[5 * 33]); o.w = pk2(s[6 * 33], s[7 * 33]);
            *(u32x4*)(WT + (size_t)(n0 + n) * K + k0 + 8 * c) = o; }
        asm volatile("s_waitcnt lgkmcnt(0)" ::: "memory");
    }
}
struct FPlain { const float* W; int N; __device__ __forceinline__ float operator()(int k, int n) const { return W[(size_t)k * N + n]; } };
struct FWin { const float* W; __device__ __forceinline__ float operator()(int k, int n) const {
    int src = n;
    if (n >= 1536 && n < 2560) { const int p = n & 63; if (p < 16) src = (n & ~63) + ((p & 1) ? 8 + (p >> 1) : (p >> 1)); }
    else if (n >= 3840) { const int p = n - 3840; if (p >= 64) return 0.f; src = 3840 + ((p & 1) ? 32 + (p >> 1) : (p >> 1)); }
    return W[(size_t)k * 3904 + src]; } };
struct FQb { const float* W; const float* g; __device__ __forceinline__ float operator()(int k, int n) const {
    if (n >= 1152) return 0.f; int src;
    if (n < 768) src = 192 * (n >> 7) + (n & 127); else { const int hh = (n - 768) >> 6, p = (n - 768) & 63; src = 192 * hh + 128 + ((p & 1) ? 32 + (p >> 1) : (p >> 1)); }
    return W[(size_t)k * 1152 + src] * g[k]; } };
struct FKVb { const float* W; const float* g; __device__ __forceinline__ float operator()(int k, int n) const {
    int src; if (n < 768) src = 256 * (n >> 7) + (n & 127); else src = 256 * ((n - 768) >> 7) + 128 + ((n - 768) & 127);
    return W[(size_t)k * 1536 + src] * g[k]; } };
struct FGate { const float* cw; const float* wr; const float* wi; __device__ __forceinline__ float operator()(int kk, int n) const {
    const int j = kk >> 7, k = kk & 127, hb = n >> 8, isI = (n >> 7) & 1, c = n & 127;
    const ptrdiff_t d = (const char*)wi - (const char*)wr; const float* wsel = (const float*)((const char*)wr + (isI ? d : (ptrdiff_t)0));
    return cw[j * 768 + 128 * hb + k] * wsel[((size_t)hb * 128 + k) * 128 + c]; } };
struct FGU { const float* wg; const float* wu; __device__ __forceinline__ float operator()(int k, int n) const {
    const int t = n >> 8, rr = n & 255, src = 128 * t + (rr & 127); const ptrdiff_t d = (const char*)wu - (const char*)wg; const float* wsel = (const float*)((const char*)wg + (rr < 128 ? (ptrdiff_t)0 : d));
    return wsel[(size_t)k * DFF + src]; } };


#define XB_TMO      128
#define XB_XCNT(j)  (256  + 64 * (j))
#define XB_XSUB(j)  (1280 + 64 * (j))
#define XB_XGEN(j)  (2304 + 64 * (j))
#define XB_TOP      3328
#define XB_TOPGEN   3392
#define XCD_BAR_WORDS 3456
#define XB_SPIN_CAP (1u << 22)
__device__ __forceinline__ unsigned xb_ld(unsigned* p)              { return __hip_atomic_load(p, __ATOMIC_RELAXED, __HIP_MEMORY_SCOPE_AGENT); }
__device__ __forceinline__ unsigned xb_add(unsigned* p, unsigned v) { return __hip_atomic_fetch_add(p, v, __ATOMIC_RELAXED, __HIP_MEMORY_SCOPE_AGENT); }
__device__ __forceinline__ unsigned xb_xcc_id() { return (unsigned)__builtin_amdgcn_s_getreg((3 << 11) | 20) & 0xFu; }
#define XB_SPIN(cond, bar) do { unsigned _sp = 0; while (cond) { __builtin_amdgcn_s_sleep(1); \
    if ((++_sp & 255u) == 0u) { if (xb_ld(&(bar)[XB_TMO])) break; if (_sp > XB_SPIN_CAP) { atomicAdd(&(bar)[XB_TMO], 1u); break; } } } } while (0)
struct XcdBarrier { unsigned* bar; unsigned x; volatile LAS unsigned* st; };
__device__ __forceinline__ XcdBarrier xcd_barrier_post(unsigned* bar, volatile LAS unsigned* st) {
    XcdBarrier b; b.bar = bar; b.x = xb_xcc_id(); b.st = st;
    if (threadIdx.x == 0) (void)xb_add(&bar[XB_XCNT(b.x)], 1u);
    return b;
}
__device__ __forceinline__ void xcd_barrier_complete(unsigned* bar, unsigned x, unsigned& nloc, unsigned& nx) {
    const unsigned G = gridDim.x * gridDim.y * gridDim.z;
    unsigned sum, cnt, mine, sp = 0u;
    for (;;) {
        sum = 0u; cnt = 0u; mine = 0u;
#pragma unroll
        for (unsigned j = 0; j < 16; ++j) { const unsigned c = xb_ld(&bar[XB_XCNT(j)]); sum += c; cnt += (c > 0u) ? 1u : 0u; mine = (j == x) ? c : mine; }
        if (sum == G) break;
        __builtin_amdgcn_s_sleep(1);
        if ((++sp & 255u) == 0u) { if (xb_ld(&bar[XB_TMO])) break; if (sp > XB_SPIN_CAP) { atomicAdd(&bar[XB_TMO], 1u); break; } }
    }
    nloc = mine > 0u ? mine : 1u; nx = cnt > 0u ? cnt : 1u;
}
__device__ __forceinline__ void xcd_barrier(unsigned* bar, volatile LAS unsigned* st) {
    asm volatile("s_waitcnt vmcnt(0)" ::: "memory");
    __syncthreads();
    if (threadIdx.x == 0) {
        const unsigned x = xb_xcc_id();
        __builtin_amdgcn_s_waitcnt(0);
        unsigned nloc = st[0], nx = st[1];
        if (nloc == 0u) { xcd_barrier_complete(bar, x, nloc, nx); st[0] = nloc; st[1] = nx; }
        const unsigned old = xb_add(&bar[XB_XSUB(x)], 1u);
        const unsigned gen = old / nloc;
        if (old + 1u == (gen + 1u) * nloc) {
            __builtin_amdgcn_fence(__ATOMIC_RELEASE, "agent");
            asm volatile("s_waitcnt vmcnt(0)" ::: "memory");
            const unsigned og = xb_add(&bar[XB_TOP], 1u);
            const unsigned tg = og / nx;
            if (og + 1u == (tg + 1u) * nx) xb_add(&bar[XB_TOPGEN], 1u);
            else XB_SPIN(xb_ld(&bar[XB_TOPGEN]) == tg, bar);
            __builtin_amdgcn_fence(__ATOMIC_ACQUIRE, "agent");
            xb_add(&bar[XB_XGEN(x)], 1u);
            asm volatile("s_waitcnt vmcnt(0)" ::: "memory");
        } else {
            XB_SPIN(xb_ld(&bar[XB_XGEN(x)]) == gen, bar);
            __builtin_amdgcn_fence(__ATOMIC_ACQUIRE, "agent");
            asm volatile("s_waitcnt vmcnt(0)" ::: "memory");
        }
    }
    __syncthreads();
}
struct Params {
    const float* x; const int* pos; const float *g_mix, *w_in, *conv_w, *conv_b, *w_r, *b_r, *w_i, *b_i, *lru_lambda, *lam_q1, *lam_k1, *lam_q2, *lam_k2, *g_sub, *g_q_a, *w_q_b, *g_kv_a, *w_kv_b,
        *w_out, *g_ffn, *w_gate, *w_up, *w_down, *g_final;
    float* out; unsigned char* ws;
    short order[N_ATT_UNITS];
};

__device__ __forceinline__ void norm_rows(const float* X, const float* g, bf16_t* ob, float* of, int gw, int NGW, int lane) {
    for (int row = gw; row < S; row += NGW) {
        const f32x4* xr = (const f32x4*)(X + (size_t)row * DM) + lane;
        f32x4 v[8]; float ss = 0.f;
#pragma unroll
        for (int j = 0; j < 8; ++j) { v[j] = xr[64 * j]; ss += (v[j][0] * v[j][0] + v[j][1] * v[j][1]) + (v[j][2] * v[j][2] + v[j][3] * v[j][3]); }
        const float rstd = 1.f / sqrtf(wave_sum(ss) * (1.f / DM) + NORM_EPS);
#pragma unroll
        for (int j = 0; j < 8; ++j) { const f32x4 gg = ((const f32x4*)g)[lane + 64 * j]; const f32x4 o = v[j] * rstd * gg;
            if (of) ((f32x4*)(of + (size_t)row * DM))[lane + 64 * j] = o;
            else { u32x2 w; w.x = pk2(o[0], o[1]); w.y = pk2(o[2], o[3]); ((u32x2*)(ob + (size_t)row * DM))[lane + 64 * j] = w; } }
    }
}

typedef const __attribute__((address_space(4))) Params* KParams;
__device__ __forceinline__ KParams kparams() { auto kp = __builtin_amdgcn_kernarg_segment_ptr(); asm volatile("" : "+s"(kp)); return (KParams)kp; }
__device__ __forceinline__ int otid() { int t = threadIdx.x; asm volatile("" : "+v"(t)); return t; }
#define WSP(T, off) ((T*)(ws + (off)))
#define GSYNC() do { asm volatile("s_waitcnt vmcnt(0) lgkmcnt(0)" ::: "memory"); grid.sync(); __builtin_amdgcn_fence(__ATOMIC_ACQUIRE, "agent"); asm volatile("s_waitcnt vmcnt(0)" ::: "memory"); } while (0)

__global__ void __launch_bounds__(512, 2) mega_fwd(Params p_unused) {
    extern __shared__ __attribute__((aligned(16))) unsigned char lds_raw[];
    LAS unsigned char* lds = (LAS unsigned char*)lds_raw;
    cg::grid_group grid = cg::this_grid();
    volatile LAS unsigned* bst = (volatile LAS unsigned*)(lds + LDS_BYTES - 64);
    if (threadIdx.x < 2) bst[threadIdx.x] = 0u;
    __syncthreads();
    { KParams P = kparams(); (void)xcd_barrier_post((unsigned*)(P->ws + WS_BAR), bst); }
#define XSYNC() do { KParams P_ = kparams(); xcd_barrier((unsigned*)(P_->ws + WS_BAR), bst); } while (0)

    {
        KParams P = kparams(); unsigned char* ws = P->ws;
        const int tid = otid(), lane = tid & 63, wave = __builtin_amdgcn_readfirstlane(tid >> 6);
        const int G = gridDim.x, bx = blockIdx.x, gw = bx * 8 + wave, NGW = G * 8, gt = bx * 512 + tid, NT = G * 512;
        float* GBR = WSP(float, WS_GB); float* GBI = GBR + DEPTH * 768; float* SPL = GBI + DEPTH * 768;
        float* TABD = WSP(float, WS_TABD); float* TABM = WSP(float, WS_TABM);
        for (int i = gt; i < (int)(PROJ_PAD / 4); i += NT) WSP(unsigned, WS_PROJ0)[i] = 0u;
        const int* pos = P->pos;
        for (int i = gt; i < S * 40; i += NT) {
            const int t = i / 40, e = i % 40; const bool dd = e < 8; const int fi = dd ? e : e - 8; const float half = dd ? 8.f : 32.f;
            const float inv = exp2f(-(float)fi / half * 18.931568569324174f);
            const float ang = (float)pos[t] * inv;
            const double rev = (double)ang * 0.15915494309189535; const float fr = (float)(rev - rint(rev));
            const float cs = __builtin_amdgcn_cosf(fr), sn = __builtin_amdgcn_sinf(fr);
            float* dst = dd ? TABD + ((size_t)t * 8 + fi) * 2 : TABM + ((size_t)t * 32 + fi) * 2; dst[0] = cs; dst[1] = sn;
        }
        {
            const float* b_r = P->b_r; const float* b_i = P->b_i; const float* w_r = P->w_r; const float* w_i = P->w_i; const float* conv_b = P->conv_b; const float* lam = P->lru_lambda;
            for (int o = gw; o < DEPTH * 768; o += NGW) {
                const int l = o / 768, cch = o % 768, hb = cch >> 7, cc = cch & 127;
                const float* wr_ = w_r + ((size_t)l * 6 + hb) * 128 * 128 + cc; const float* wi_ = w_i + ((size_t)l * 6 + hb) * 128 * 128 + cc; const float* cb = conv_b + l * 768 + hb * 128;
                float sr = 0.f, si = 0.f;
#pragma unroll
                for (int k = lane; k < 128; k += 64) { const float cv = cb[k]; sr += cv * wr_[k * 128]; si += cv * wi_[k * 128]; }
                sr = wave_sum(sr); si = wave_sum(si);
                if (lane == 0) { GBR[o] = sr + b_r[o]; GBI[o] = si + b_i[o]; SPL[o] = 8.f * log1pf(expf(-lam[o])); }
            }
        }
        LAS float* scr = (LAS float*)(lds + wave * 8448);
#pragma unroll 1
        for (int l = 0; l < DEPTH; ++l) {
            unsigned char* wb = ws + WS_W + (size_t)l * LAYER_W;
            conv_mat(FWin{P->w_in + (size_t)l * DM * 3904}, (bf16_t*)(wb + W_WIN), NPROJ, DM, scr, gw, NGW, lane);
            conv_mat(FQb{P->w_q_b + (size_t)l * 512 * 1152, P->g_q_a + l * 512}, (bf16_t*)(wb + W_WQB), NQ, 512, scr, (gw + 517) % NGW, NGW, lane);
            conv_mat(FKVb{P->w_kv_b + (size_t)l * 256 * 1536, P->g_kv_a + l * 256}, (bf16_t*)(wb + W_WKVB), NKV, 256, scr, (gw + 837) % NGW, NGW, lane);
            conv_mat(FGate{P->conv_w + (size_t)l * 4 * 768, P->w_r + (size_t)l * 6 * 128 * 128, P->w_i + (size_t)l * 6 * 128 * 128}, (bf16_t*)(wb + W_WG), 1536, 512, scr, (gw + 1029) % NGW, NGW, lane);
            conv_mat(FPlain{P->w_out + (size_t)l * DM * DM, DM}, (bf16_t*)(wb + W_WOUT), DM, DM, scr, (gw + 1413) % NGW, NGW, lane);
            conv_mat(FGU{P->w_gate + (size_t)l * DM * DFF, P->w_up + (size_t)l * DM * DFF}, (bf16_t*)(wb + W_WGU), NGU, DM, scr, gw, NGW, lane);
            conv_mat(FPlain{P->w_down + (size_t)l * DFF * DM, DM}, (bf16_t*)(wb + W_WDOWN), DM, DFF, scr, gw, NGW, lane);
        }
    }
    GSYNC();

#pragma unroll 1
    for (int l = 0; l < DEPTH; ++l) {
        { KParams P = kparams(); unsigned char* ws = P->ws; const int tid = otid(), lane = tid & 63, wave = __builtin_amdgcn_readfirstlane(tid >> 6);
          norm_rows((l == 0) ? P->x : WSP(const float, WS_X), P->g_mix + l * DM, WSP(bf16_t, WS_HN), nullptr, blockIdx.x * 8 + wave, gridDim.x * 8, lane); }
        XSYNC();
        { KParams P = kparams(); unsigned char* ws = P->ws; unsigned char* wb = ws + WS_W + (size_t)l * LAYER_W;
          pg8::Gemm g{WSP(const bf16_t, WS_HN), (const bf16_t*)(wb + W_WIN), DM, DM, 0}; pg8::StaticOrder so; so.init(S, NPROJ, gridDim.x, blockIdx.x);
          EpiProj E{WSP(bf16_t, WS_PROJ0 + PROJ_PAD), WSP(const float, WS_TABD), WSP(const float, WS_TABM), WSP(float, WS_SSQ), WSP(bf16_t, WS_KV)}; pg8::gemm_phase<EpiProj, false>(lds, g, so, E); }
        XSYNC();
        { KParams P = kparams(); unsigned char* ws = P->ws; unsigned char* wb = ws + WS_W + (size_t)l * LAYER_W;
          pg8::Gemm g{WSP(const bf16_t, WS_PROJ0 + PROJ_PAD) + 3072, (const bf16_t*)(wb + W_WQB), NPROJ, 512, 0}; pg8::StaticOrder so; so.init(S, NQ, gridDim.x, blockIdx.x);
          EpiScaleRope E{WSP(bf16_t, WS_Q), NQ, WSP(const float, WS_SSQ), 2, 1.f / 512.f, WSP(const float, WS_TABM), 3}; pg8::gemm_phase<EpiScaleRope, false>(lds, g, so, E); }
        { KParams P = kparams(); unsigned char* ws = P->ws; unsigned char* wb = ws + WS_W + (size_t)l * LAYER_W;
          pg8::Gemm g{WSP(const bf16_t, WS_PROJ0 + PROJ_PAD) + 3584, (const bf16_t*)(wb + W_WKVB), NPROJ, 256, 0}; pg8::StaticOrder so; so.init(S, NKV, gridDim.x, (blockIdx.x + 96) % gridDim.x);
          EpiScaleRope E{WSP(bf16_t, WS_KV), NKVP, WSP(const float, WS_SSQ) + 8, 1, 1.f / 256.f, WSP(const float, WS_TABM), 1000}; pg8::gemm_phase<EpiScaleRope, false>(lds, g, so, E); }
        { KParams P = kparams(); unsigned char* ws = P->ws; unsigned char* wb = ws + WS_W + (size_t)l * LAYER_W; const bf16_t* PROJ = WSP(const bf16_t, WS_PROJ0 + PROJ_PAD);
          float* GBR = WSP(float, WS_GB);
          pg8::Gemm g{PROJ, (const bf16_t*)(wb + W_WG), NPROJ, 512, 256}; pg8::StaticOrder so; so.init(S, 1536, gridDim.x, (blockIdx.x + 160) % gridDim.x);
          EpiGate E{PROJ, P->conv_w + (size_t)l * 4 * 768, P->conv_b + l * 768, GBR + l * 768, GBR + (DEPTH + l) * 768, GBR + (2 * DEPTH + l) * 768, WSP(float, WS_A), WSP(float, WS_B)};
          pg8::gemm_phase<EpiGate, true>(lds, g, so, E); }
        XSYNC();
        { KParams P = kparams(); unsigned char* ws = P->ws; const int tid = otid(); const float* Ab = WSP(const float, WS_A); const float* Bb = WSP(const float, WS_B); float* CP = WSP(float, WS_CP); float* CH = WSP(float, WS_CH);
          for (int it = blockIdx.x; it < 256; it += gridDim.x) {
            if (tid < 384) {
              const int tc = it >> 1, c = 384 * (it & 1) + tid, t0 = 64 * tc;
              float Pp = 1.f, H = 0.f;
#pragma unroll
              for (int t = 0; t < 64; ++t) { const float a = Ab[(size_t)(t0 + t) * 768 + c], b = Bb[(size_t)(t0 + t) * 768 + c]; H = a * H + b; Pp *= a; }
              CP[tc * 768 + c] = Pp; CH[tc * 768 + c] = H;
            }
          } }
        { KParams P = kparams(); unsigned char* ws = P->ws; const int tid = otid(), lane = tid & 63;
          const float linit = 0.8f - 0.6f * expf(-0.3f * (float)l);
          const float s1 = wave_sum(P->lam_q1[l * 64 + lane] * P->lam_k1[l * 64 + lane]), s2 = wave_sum(P->lam_q2[l * 64 + lane] * P->lam_k2[l * 64 + lane]);
          AttnArgs a{WSP(const bf16_t, WS_PROJ0 + PROJ_PAD), WSP(const bf16_t, WS_Q), WSP(const bf16_t, WS_KV), WSP(bf16_t, WS_MIX), WSP(float, WS_STASH), WSP(float, WS_PARTO), WSP(float, WS_PARTML),
                     P->g_sub + l * 128, expf(s1) - expf(s2) + linit, 1.f - linit};
          unsigned* qctr = (unsigned*)(ws + WS_BAR) + XCD_BAR_WORDS + 64 * l;
          bool first = true;
#pragma unroll 1
          for (;;) {
              if (tid == 0) { const unsigned idx = first ? (unsigned)blockIdx.x : (unsigned)gridDim.x + xb_add(qctr, 1u);
                              bst[2] = (idx < (unsigned)N_ATT_UNITS) ? (unsigned)(int)P->order[idx] : 0xffffffffu; }
              first = false;
              __syncthreads();
              const int u = __builtin_amdgcn_readfirstlane((int)bst[2]);
              if (u < 0) break;
              attn_dispatch(lds, a, u);
          } }
        XSYNC();
        { KParams P = kparams(); unsigned char* ws = P->ws; const int tid = otid(); const float* Ab = WSP(const float, WS_A); const float* Bb = WSP(const float, WS_B); const float* CP = WSP(const float, WS_CP); const float* CH = WSP(const float, WS_CH);
          const bf16_t* PROJ = WSP(const bf16_t, WS_PROJ0 + PROJ_PAD); bf16_t* MIX = WSP(bf16_t, WS_MIX);
          for (int it = blockIdx.x; it < 256; it += gridDim.x) {
            if (tid < 384) {
              const int tc = it >> 1, c = 384 * (it & 1) + tid, t0 = 64 * tc;
              float H = 0.f;
#pragma unroll 64
              for (int j = 0; j < tc; ++j) H = CP[j * 768 + c] * H + CH[j * 768 + c];
#pragma unroll 1
              for (int tb = 0; tb < 64; tb += 16) {
                  float av[16], bv[16]; unsigned yv[16];
#pragma unroll
                  for (int t = 0; t < 16; ++t) { av[t] = Ab[(size_t)(t0 + tb + t) * 768 + c]; bv[t] = Bb[(size_t)(t0 + tb + t) * 768 + c]; yv[t] = PROJ[(size_t)(t0 + tb + t) * NPROJ + 768 + c]; }
                  __builtin_amdgcn_sched_barrier(0);
#pragma unroll
                  for (int t = 0; t < 16; ++t) { H = av[t] * H + bv[t]; MIX[(size_t)(t0 + tb + t) * DM + c] = (bf16_t)f2bf(H * gelu_tanh(bf2f(yv[t]))); }
              }
            }
          } }
        { KParams P = kparams(); unsigned char* ws = P->ws; const int tid = otid(), lane = tid & 63, wave = __builtin_amdgcn_readfirstlane(tid >> 6);
          const float linit = 0.8f - 0.6f * expf(-0.3f * (float)l);
          const float s1 = wave_sum(P->lam_q1[l * 64 + lane] * P->lam_k1[l * 64 + lane]), s2 = wave_sum(P->lam_q2[l * 64 + lane] * P->lam_k2[l * 64 + lane]);
          const float lam = expf(s1) - expf(s2) + linit, oml = 1.f - linit;
          const float* PO = WSP(const float, WS_PARTO); const float* PML = WSP(const float, WS_PARTML); bf16_t* MIX = WSP(bf16_t, WS_MIX);
          const f32x2 gs = *(const f32x2*)(P->g_sub + l * 128 + 2 * lane);
          const int NGW = gridDim.x * 8;
#pragma unroll 1
          for (int rr = blockIdx.x * 8 + wave; rr < 4096; rr += NGW) {
              f32x2 ml[28], po[28];
#pragma unroll
              for (int p = 0; p < 28; ++p) { ml[p] = *(const f32x2*)(PML + ((size_t)p * 4096 + rr) * 2); po[p] = *(const f32x2*)(PO + ((size_t)p * 4096 + rr) * 128 + 2 * lane); }
              bf16_t* mrow = MIX + (size_t)(4096 + rr) * DM;
#pragma unroll
              for (int hh = 0; hh < 4; ++hh) {
                  f32x2 om[2];
#pragma unroll
                  for (int m = 0; m < 2; ++m) { const int p0 = (hh * 2 + m) * 2;
                      const float M = fmaxf(ml[p0][0], ml[p0 + 1][0]), w0 = __builtin_amdgcn_exp2f((ml[p0][0] - M) * C_DIFF), w1 = __builtin_amdgcn_exp2f((ml[p0 + 1][0] - M) * C_DIFF);
                      const float inv = 1.f / (w0 * ml[p0][1] + w1 * ml[p0 + 1][1]);
                      om[m] = (po[p0] * w0 + po[p0 + 1] * w1) * inv; }
                  const f32x2 o = om[0] - om[1] * lam;
                  const float ss = wave_sum(o[0] * o[0] + o[1] * o[1]);
                  const float rs = oml / sqrtf(ss * (1.f / 128.f) + SUBLN_EPS);
                  ((unsigned*)(mrow + 768 + 128 * hh))[lane] = pk2(o[0] * rs * gs[0], o[1] * rs * gs[1]);
              }
#pragma unroll
              for (int hh = 0; hh < 6; ++hh) { const int p0 = (8 + hh) * 2;
                  const float M = fmaxf(ml[p0][0], ml[p0 + 1][0]), w0 = __builtin_amdgcn_exp2f((ml[p0][0] - M) * C_MLA), w1 = __builtin_amdgcn_exp2f((ml[p0 + 1][0] - M) * C_MLA);
                  const float inv = 1.f / (w0 * ml[p0][1] + w1 * ml[p0 + 1][1]);
                  const f32x2 o = (po[p0] * w0 + po[p0 + 1] * w1) * inv;
                  ((unsigned*)(mrow + 1280 + 128 * hh))[lane] = pk2(o[0], o[1]);
              }
          } }
        XSYNC();
        { KParams P = kparams(); unsigned char* ws = P->ws; unsigned char* wb = ws + WS_W + (size_t)l * LAYER_W;
          pg8::Gemm g{WSP(const bf16_t, WS_MIX), (const bf16_t*)(wb + W_WOUT), DM, DM, 0}; pg8::StaticOrder so; so.init(S, DM, gridDim.x, blockIdx.x);
          EpiResid E{(l == 0) ? P->x : WSP(const float, WS_X), WSP(float, WS_X)}; pg8::gemm_phase<EpiResid, false>(lds, g, so, E); }
        XSYNC();
        { KParams P = kparams(); unsigned char* ws = P->ws; const int tid = otid(), lane = tid & 63, wave = __builtin_amdgcn_readfirstlane(tid >> 6);
          norm_rows(WSP(const float, WS_X), P->g_ffn + l * DM, WSP(bf16_t, WS_HN), nullptr, blockIdx.x * 8 + wave, gridDim.x * 8, lane); }
        XSYNC();
        { KParams P = kparams(); unsigned char* ws = P->ws; unsigned char* wb = ws + WS_W + (size_t)l * LAYER_W;
          pg8::Gemm g{WSP(const bf16_t, WS_HN), (const bf16_t*)(wb + W_WGU), DM, DM, 0}; pg8::StaticOrder so; so.init(S, NGU, gridDim.x, blockIdx.x);
          EpiSwiGLU E{WSP(bf16_t, WS_ACT)}; pg8::gemm_phase<EpiSwiGLU, false>(lds, g, so, E); }
        XSYNC();
        { KParams P = kparams(); unsigned char* ws = P->ws; unsigned char* wb = ws + WS_W + (size_t)l * LAYER_W;
          pg8::Gemm g{WSP(const bf16_t, WS_ACT), (const bf16_t*)(wb + W_WDOWN), DFF, DFF, 0}; pg8::StaticOrder so; so.init(S, DM, gridDim.x, blockIdx.x);
          EpiResid E{WSP(const float, WS_X), WSP(float, WS_X)}; pg8::gemm_phase<EpiResid, false>(lds, g, so, E); }
        XSYNC();
    }
    { KParams P = kparams(); unsigned char* ws = P->ws; const int tid = otid(), lane = tid & 63, wave = __builtin_amdgcn_readfirstlane(tid >> 6);
      norm_rows(WSP(const float, WS_X), P->g_final, nullptr, P->out, blockIdx.x * 8 + wave, gridDim.x * 8, lane); }
}

extern "C" void kernel_launch(void* const* d_in, const int* in_sizes, int n_in, void* d_out, int out_size, void* d_ws, size_t ws_size, hipStream_t stream) {
    static int grid = 0;
    if (grid == 0) {
        if (n_in != 26 || ws_size < WS_END) { fprintf(stderr, "kernel_launch: unexpected n_in %d / ws_size %zu (need %zu)\n", n_in, ws_size, (size_t)WS_END); grid = -1; return; }
        int dev = 0, cus = 0, per_cu = 0;
        hipGetDevice(&dev); hipDeviceGetAttribute(&cus, hipDeviceAttributeMultiprocessorCount, dev);
        hipFuncSetAttribute((const void*)mega_fwd, hipFuncAttributeMaxDynamicSharedMemorySize, LDS_BYTES);
        hipOccupancyMaxActiveBlocksPerMultiprocessor(&per_cu, (const void*)mega_fwd, 512, LDS_BYTES);
        if (per_cu < 1) per_cu = 1;
        grid = cus * per_cu;
        (void)hipGetLastError();
    }
    if (grid < 0) return;
    if (hipMemsetAsync((char*)d_ws + WS_BAR, 0, (XCD_BAR_WORDS + 64 * DEPTH) * 4, stream) != hipSuccess) { fprintf(stderr, "memset failed\n"); return; }
    static short order_tab[N_ATT_UNITS];
    static bool sched_ok = false;
    if (!sched_ok) {
        int cost[N_ATT_UNITS], order[N_ATT_UNITS];
        for (int u = 0; u < N_ATT_UNITS; ++u) {
            int qb, wgt;
            if (u < 64) { qb = u >> 2; wgt = 48; } else if (u < 160) { qb = (u - 64) / 6; wgt = 40; } else if (u < 416) { qb = 16 + ((u - 160) >> 4); wgt = 12; } else { qb = 16 + ((u - 416) >> 1) / 6; wgt = 20; }
            cost[u] = wgt * (4 * qb + 4); order[u] = u;
        }
        for (int i = 1; i < N_ATT_UNITS; ++i) { const int u = order[i]; int j = i - 1; while (j >= 0 && (cost[order[j]] < cost[u])) { order[j + 1] = order[j]; --j; } order[j + 1] = u; }
        for (int i = 0; i < N_ATT_UNITS; ++i) order_tab[i] = (short)order[i];
        sched_ok = true;
    }
    Params p{};
    for (int i = 0; i < N_ATT_UNITS; ++i) p.order[i] = order_tab[i];
    p.x = (const float*)d_in[0]; p.pos = (const int*)d_in[1]; p.g_mix = (const float*)d_in[2]; p.w_in = (const float*)d_in[3]; p.conv_w = (const float*)d_in[4]; p.conv_b = (const float*)d_in[5];
    p.w_r = (const float*)d_in[6]; p.b_r = (const float*)d_in[7]; p.w_i = (const float*)d_in[8]; p.b_i = (const float*)d_in[9]; p.lru_lambda = (const float*)d_in[10];
    p.lam_q1 = (const float*)d_in[11]; p.lam_k1 = (const float*)d_in[12]; p.lam_q2 = (const float*)d_in[13]; p.lam_k2 = (const float*)d_in[14]; p.g_sub = (const float*)d_in[15];
    p.g_q_a = (const float*)d_in[16]; p.w_q_b = (const float*)d_in[17]; p.g_kv_a = (const float*)d_in[18]; p.w_kv_b = (const float*)d_in[19]; p.w_out = (const float*)d_in[20];
    p.g_ffn = (const float*)d_in[21]; p.w_gate = (const float*)d_in[22]; p.w_up = (const float*)d_in[23]; p.w_down = (const float*)d_in[24]; p.g_final = (const float*)d_in[25];
    p.out = (float*)d_out; p.ws = (unsigned char*)d_ws;
    void* args[] = {&p};
    hipError_t e = hipLaunchCooperativeKernel((const void*)mega_fwd, dim3(grid), dim3(512), args, LDS_BYTES, stream);
    if (e != hipSuccess) fprintf(stderr, "cooperative launch failed: %s (grid %d)\n", hipGetErrorString(e), grid);
}
```

```cpp
#include <hip/hip_runtime.h>
#include <hip/hip_cooperative_groups.h>
#include <cstdio>
#include <cstdint>
namespace cg = cooperative_groups;

#define LAS __attribute__((address_space(3)))
typedef unsigned short bf16_t;
typedef short bf16x8 __attribute__((ext_vector_type(8)));
typedef short s16x4 __attribute__((ext_vector_type(4)));
typedef float f32x4 __attribute__((ext_vector_type(4)));
typedef float f32x2 __attribute__((ext_vector_type(2)));
typedef float f32x16 __attribute__((ext_vector_type(16)));
typedef unsigned u32x4 __attribute__((ext_vector_type(4)));
typedef unsigned u32x2 __attribute__((ext_vector_type(2)));

constexpr int S = 8192, DM = 2048, DEPTH = 4;
constexpr int NPROJ = 4096;
constexpr int DFF = 5632;
constexpr int NQ = 1280;
constexpr int NKV = 1536;
constexpr int NKVP = 1600;
constexpr int NGU = 2 * DFF;
constexpr float NORM_EPS = 1e-6f, SUBLN_EPS = 1e-5f;

constexpr size_t MiB = 1u << 20;
constexpr size_t WS_SSQ = 0;
constexpr size_t WS_GB = 1 * MiB;
constexpr size_t WS_TABD = 2 * MiB;
constexpr size_t WS_TABM = 3 * MiB;
constexpr size_t WS_CP = 5 * MiB, WS_CH = 6 * MiB;
constexpr size_t WS_BAR = 7 * MiB + 512 * 1024;
constexpr size_t WS_ORDER = 7 * MiB;
constexpr size_t WS_W = 8 * MiB;
constexpr size_t W_WIN = 0, W_WQB = 16 * MiB, W_WKVB = 18 * MiB, W_WG = 19 * MiB, W_WOUT = 21 * MiB, W_WGU = 29 * MiB, W_WDOWN = 73 * MiB, LAYER_W = 95 * MiB;
constexpr size_t WS_X = WS_W + 4 * LAYER_W;
constexpr size_t WS_HN = WS_X + 64 * MiB;
constexpr size_t WS_MIX = WS_HN + 32 * MiB;
constexpr size_t WS_PROJ0 = WS_MIX + 32 * MiB;
constexpr size_t PROJ_PAD = 4 * NPROJ * 2;
constexpr size_t WS_ACT = WS_PROJ0 + 1 * MiB;
constexpr size_t WS_Q = WS_PROJ0 + 65 * MiB;
constexpr size_t WS_KV = WS_Q + 20 * MiB;
constexpr size_t WS_A = WS_KV + 26 * MiB;
constexpr size_t WS_B = WS_A + 24 * MiB;
constexpr size_t WS_STASH = WS_B + 24 * MiB;
constexpr size_t WS_PARTO = WS_STASH + 16 * MiB;
constexpr size_t WS_PARTML = WS_PARTO + 56 * MiB;
constexpr size_t WS_END = WS_PARTML + 1 * MiB;
static_assert(WS_ACT + (size_t)S * DFF * 2 <= WS_A, "ACT overlay");

constexpr int LDS_BYTES = 147456;

__device__ __forceinline__ unsigned f2bf(float f) { unsigned u = __builtin_bit_cast(unsigned, f); return (u + 0x7fffu + ((u >> 16) & 1u)) >> 16; }
__device__ __forceinline__ unsigned pk2(float lo, float hi) { return f2bf(lo) | (f2bf(hi) << 16); }
__device__ __forceinline__ float bf2f(unsigned v) { return __builtin_bit_cast(float, v << 16); }
typedef float f32x2_t_ __attribute__((ext_vector_type(2))); typedef __bf16 bf16x2_t_ __attribute__((ext_vector_type(2)));
__device__ __forceinline__ unsigned cvt_pk_bf16(float lo, float hi) { const f32x2_t_ v = {lo, hi}; const bf16x2_t_ b = __builtin_convertvector(v, bf16x2_t_); return __builtin_bit_cast(unsigned, b); }
__device__ __forceinline__ float wave_sum(float v) {
#pragma unroll
    for (int o = 1; o < 64; o <<= 1) v += __shfl_xor(v, o);
    return v;
}
__device__ __forceinline__ float fexp(float x) { return __builtin_amdgcn_exp2f(x * 1.4426950408889634f); }
__device__ __forceinline__ float sigmoidf_(float x) { return __builtin_amdgcn_rcpf(1.f + fexp(-x)); }
__device__ __forceinline__ float gelu_tanh(float y) { const float z = 0.7978845608028654f * (y + 0.044715f * y * y * y); const float t = 1.f - 2.f * __builtin_amdgcn_rcpf(fexp(2.f * z) + 1.f); return 0.5f * y * (1.f + t); }
__device__ __forceinline__ void rope4(f32x4& v0, f32x4& v1, const float* cs) {
    const f32x4 t0 = *(const f32x4*)cs, t1 = *(const f32x4*)(cs + 4);
    f32x4 a, b;
    a[0] = v0[0] * t0[0] - v0[1] * t0[1]; a[1] = v0[1] * t0[0] + v0[0] * t0[1];
    a[2] = v0[2] * t0[2] - v0[3] * t0[3]; a[3] = v0[3] * t0[2] + v0[2] * t0[3];
    b[0] = v1[0] * t1[0] - v1[1] * t1[1]; b[1] = v1[1] * t1[0] + v1[0] * t1[1];
    b[2] = v1[2] * t1[2] - v1[3] * t1[3]; b[3] = v1[3] * t1[2] + v1[2] * t1[3];
    v0 = a; v1 = b;
}

namespace pg8 {
constexpr int BM = 256, BK = 64, HALF = 128, HTB = HALF * BK * 2, STAGE_BYTES = 8 * HTB, NXCD = 8, WGM = 8;
__host__ __device__ __forceinline__ int lds_byte(int r, int c) { const int st = (r >> 4) * 2 + (c >> 5), rr = r & 15, cc = c & 31, ob = rr * 64 + cc * 2; return st * 1024 + (ob ^ (((ob >> 9) & 1) << 5)); }
__host__ __device__ __forceinline__ void stage_rc(int b, int& R, int& C) { const int st = b / 1024, sb = b % 1024, swz = sb ^ (((sb >> 9) & 1) << 5); R = (st >> 1) * 16 + swz / 64; C = (st & 1) * 32 + (swz % 64) / 2; }
__host__ __device__ __forceinline__ int perm32(int rho) { const int n = rho >> 4, i = rho & 15; return 8 * (i >> 2) + 4 * n + (i & 3); }

struct Unit { int pm, pn; };
struct Gemm { const bf16_t* A; const bf16_t* Bt; int lda, K; int a_pn_bytes; };

struct StaticOrder {
    int nM, nN, nwg, G, c;
    __device__ void init(int M, int N, int G_, int c_) { nM = M / BM; nN = N / BM; nwg = nM * nN; G = G_; c = c_; }
    __device__ bool next(int i, Unit& u) const {
        const long L = (long)i * G + c; if (L >= nwg) return false;
        int wgid = (int)L; { const int q = nwg / NXCD, r = nwg % NXCD, xcd = wgid % NXCD, off = wgid / NXCD; wgid = (xcd < r ? xcd * (q + 1) : r * (q + 1) + (xcd - r) * q) + off; }
        const int nig = WGM * nN, gid = wgid / nig, fm = gid * WGM, gsz = (nM - fm) < WGM ? (nM - fm) : WGM;
        u.pm = fm + ((wgid % nig) % gsz); u.pn = (wgid % nig) / gsz; return true;
    }
};

template <class Epi, bool CONV>
__device__ __forceinline__ void gemm_phase(LAS unsigned char* lds, const Gemm g, const StaticOrder& S_, const Epi& E) {
    int tid_ = threadIdx.x; asm volatile("" : "+v"(tid_));
    const int tid = tid_, wid = __builtin_amdgcn_readfirstlane(tid >> 6), lane = tid & 63, wr = wid >> 2, wc = wid & 3, fr = lane & 15, fq = lane >> 4;
    const int K = g.K, nt = K / BK, lda = g.lda;
    unsigned voffA[2], voffB[2];
#pragma unroll
    for (int i = 0; i < 2; ++i) { int R, C; stage_rc(tid * 16 + i * 8192, R, C); const int Rb = Epi::PERM ? ((R & ~31) + perm32(R & 31)) : R;
        voffA[i] = (unsigned)(R * lda + C) * 2u; voffB[i] = (unsigned)(Rb * K + C) * 2u; }
    const size_t kstep = (size_t)(BK * 2);
    const size_t hstepA = (size_t)HALF * lda * 2, hstepB = (size_t)HALF * K * 2;
    const size_t tstepA = 2 * hstepA, tstepB = 2 * hstepB;
    const unsigned ldsw = (unsigned)wid * 1024u;
    const int aoff = lds_byte(wr * 64 + fr, fq * 8), boff = lds_byte(wc * 32 + fr, fq * 8);
    auto akoff = [&](int t) -> long { if constexpr (CONV) return ((long)((t >> 1) - 3) * lda + (t & 1) * 64) * 2; else return (long)t * 128; };
#define PG8_SA(b, h) (((b) * 2 + (h)) * HTB)
#define PG8_SB(b, h) ((4 + (b) * 2 + (h)) * HTB)
#define PG8_STAGE(bufoff, gbase, voff) do { _Pragma("unroll") for (int _i = 0; _i < 2; ++_i) \
        __builtin_amdgcn_global_load_lds((const unsigned*)((const char*)(gbase) + (voff)[_i]), (LAS unsigned*)(lds + (bufoff) + ldsw + _i * 8192), 16, 0, 0); } while (0)
#define PG8_LDA(dst, b, h) do { _Pragma("unroll") for (int m = 0; m < 4; ++m) _Pragma("unroll") for (int k = 0; k < 2; ++k) dst[m][k] = *(const LAS bf16x8*)(lds + PG8_SA(b, h) + aoff + m * 2048 + k * 1024); } while (0)
#define PG8_LDB(dst, b, h) do { _Pragma("unroll") for (int n = 0; n < 2; ++n) _Pragma("unroll") for (int k = 0; k < 2; ++k) dst[n][k] = *(const LAS bf16x8*)(lds + PG8_SB(b, h) + boff + n * 2048 + k * 1024); } while (0)
#define PG8_MMA(ai, bj, At, Bt) do { __builtin_amdgcn_s_setprio(1); _Pragma("unroll") for (int m = 0; m < 4; ++m) _Pragma("unroll") for (int n = 0; n < 2; ++n) _Pragma("unroll") for (int k = 0; k < 2; ++k) \
        acc[ai][bj][m][n] = __builtin_amdgcn_mfma_f32_16x16x32_bf16(Bt[n][k], At[m][k], acc[ai][bj][m][n], 0, 0, 0); __builtin_amdgcn_s_setprio(0); } while (0)
#define PG8_WAIT_V(n) asm volatile("s_waitcnt vmcnt(" #n ")" ::: "memory")
#define PG8_WAIT_L(n) asm volatile("s_waitcnt lgkmcnt(" #n ")" ::: "memory")
#define PG8_BAR __builtin_amdgcn_s_barrier()
#define PG8_SCHED __builtin_amdgcn_sched_barrier(0)
    Unit cur, nxt; int ui = 0;
    if (!S_.next(0, cur)) return;
    f32x4 acc[2][2][4][2];
#pragma unroll
    for (int a = 0; a < 2; ++a)
#pragma unroll
        for (int b = 0; b < 2; ++b)
#pragma unroll
            for (int m = 0; m < 4; ++m)
#pragma unroll
                for (int n = 0; n < 2; ++n) acc[a][b][m][n] = (f32x4){0.f, 0.f, 0.f, 0.f};
    bf16x8 At[4][2], B0[2][2], B1[2][2];
    const char* cA = (const char*)g.A + (size_t)cur.pm * tstepA + (size_t)cur.pn * g.a_pn_bytes; const char* cB = (const char*)g.Bt + (size_t)cur.pn * tstepB;
    {
        const char* a0 = cA + akoff(0); const char* a1p = cA + akoff(1);
        PG8_STAGE(PG8_SB(0, 0), cB, voffB); PG8_STAGE(PG8_SB(0, 1), cB + hstepB, voffB); PG8_STAGE(PG8_SA(0, 0), a0, voffA); PG8_STAGE(PG8_SA(0, 1), a0 + hstepA, voffA);
        if (wr == 1) PG8_BAR;
        PG8_WAIT_V(2); PG8_BAR;
        PG8_STAGE(PG8_SB(1, 0), cB + kstep, voffB); PG8_STAGE(PG8_SA(1, 0), a1p, voffA); PG8_STAGE(PG8_SB(1, 1), cB + hstepB + kstep, voffB);
        PG8_WAIT_V(6); PG8_BAR;
    }
    for (;;) {
        const bool has_next = S_.next(ui + 1, nxt);
        const char* nA = has_next ? (const char*)g.A + (size_t)nxt.pm * tstepA + (size_t)nxt.pn * g.a_pn_bytes : cA; const char* nB = has_next ? (const char*)g.Bt + (size_t)nxt.pn * tstepB : cB;
        for (int t = 0; t < nt; t += 2) {
            const bool last = (t == nt - 2);
            const char* a1 = cA + akoff(t + 1);
            const char* a2 = last ? nA + akoff(0) : cA + akoff(t + 2); const char* b2 = last ? nB : cB + (size_t)(t + 2) * kstep;
            const char* a3 = last ? nA + akoff(1) : cA + akoff(t + 3); const char* b3 = b2 + kstep;
            PG8_LDB(B0, 0, 0); PG8_LDB(B1, 0, 1); PG8_SCHED; PG8_LDA(At, 0, 0); PG8_STAGE(PG8_SA(1, 1), a1 + hstepA, voffA);
            PG8_WAIT_V(8); PG8_WAIT_L(0); PG8_BAR; PG8_MMA(0, 0, At, B0); PG8_MMA(0, 1, At, B1); PG8_BAR; PG8_SCHED;
            PG8_LDA(At, 0, 1); PG8_STAGE(PG8_SB(0, 0), b2, voffB); PG8_STAGE(PG8_SB(0, 1), b2 + hstepB, voffB); PG8_STAGE(PG8_SA(0, 0), a2, voffA);
            PG8_WAIT_V(8); PG8_WAIT_L(0); PG8_BAR; PG8_MMA(1, 0, At, B0); PG8_MMA(1, 1, At, B1); PG8_BAR; PG8_SCHED;
            PG8_LDB(B0, 1, 0); PG8_LDB(B1, 1, 1); PG8_SCHED; PG8_LDA(At, 1, 0); PG8_STAGE(PG8_SA(0, 1), a2 + hstepA, voffA);
            PG8_WAIT_V(8); PG8_WAIT_L(0); PG8_BAR; PG8_MMA(0, 0, At, B0); PG8_MMA(0, 1, At, B1); PG8_BAR; PG8_SCHED;
            PG8_LDA(At, 1, 1); PG8_STAGE(PG8_SB(1, 0), b3, voffB); PG8_STAGE(PG8_SB(1, 1), b3 + hstepB, voffB); PG8_STAGE(PG8_SA(1, 0), a3, voffA);
            PG8_WAIT_V(8); PG8_WAIT_L(0); PG8_BAR; PG8_MMA(1, 0, At, B0); PG8_MMA(1, 1, At, B1); PG8_BAR; PG8_SCHED;
        }
        if (wr == 0) PG8_BAR;
        E(acc, cur, wr, wc, fr, fq);
        if (!has_next) break;
#pragma unroll
        for (int a = 0; a < 2; ++a)
#pragma unroll
            for (int b = 0; b < 2; ++b)
#pragma unroll
                for (int m = 0; m < 4; ++m)
#pragma unroll
                    for (int n = 0; n < 2; ++n) acc[a][b][m][n] = (f32x4){0.f, 0.f, 0.f, 0.f};
        cur = nxt; cA = nA; cB = nB; ++ui;
        if (wr == 1) PG8_BAR;
    }
    PG8_WAIT_V(0);
    PG8_BAR;
#undef PG8_SA
#undef PG8_SB
#undef PG8_STAGE
#undef PG8_LDA
#undef PG8_LDB
#undef PG8_MMA
#undef PG8_WAIT_V
#undef PG8_WAIT_L
#undef PG8_BAR
#undef PG8_SCHED
}
}

typedef const f32x4 (&AccT)[2][2][4][2];

struct EpiProj {
    static constexpr bool PERM = true;
    bf16_t* O; const float* tabd; const float* tabm; float* ssqp; bf16_t* KV;
    __device__ __forceinline__ void operator()(AccT acc, const pg8::Unit& u, int wr, int wc, int fr, int fq) const {
        const int row0 = u.pm * 256 + wr * 64 + fr, col0 = u.pn * 256 + wc * 32 + 8 * fq, pn = u.pn;
        const bool ropeD = (pn >= 6 && pn < 10) && ((wc & 1) == 0) && (fq < 2);
        const bool ropeM = (pn == 15) && (wc < 2);
        const int slot = (pn == 12 || pn == 13) ? (pn - 12) * 4 + wc : (pn == 14 ? 8 + wc : -1);
#pragma unroll
        for (int ai = 0; ai < 2; ++ai)
#pragma unroll
            for (int m = 0; m < 4; ++m) {
                const int row = row0 + ai * 128 + m * 16; bf16_t* rowp = O + (size_t)row * NPROJ + col0; float ss = 0.f;
#pragma unroll
                for (int bj = 0; bj < 2; ++bj) {
                    f32x4 v0 = acc[ai][bj][m][0], v1 = acc[ai][bj][m][1];
                    if (ropeD) rope4(v0, v1, tabd + (size_t)row * 16 + 8 * fq);
                    if (ropeM && bj == 0) rope4(v0, v1, tabm + (size_t)row * 64 + (16 * wc + 4 * fq) * 2);
                    ss += (v0[0] * v0[0] + v0[1] * v0[1]) + (v0[2] * v0[2] + v0[3] * v0[3]) + (v1[0] * v1[0] + v1[1] * v1[1]) + (v1[2] * v1[2] + v1[3] * v1[3]);
                    u32x4 w; w.x = cvt_pk_bf16(v0[0], v0[1]); w.y = cvt_pk_bf16(v0[2], v0[3]); w.z = cvt_pk_bf16(v1[0], v1[1]); w.w = cvt_pk_bf16(v1[2], v1[3]);
                    *(u32x4*)(rowp + bj * 128) = w;
                    if (ropeM && bj == 0) *(u32x4*)(KV + (size_t)row * NKVP + 1536 + wc * 32 + 8 * fq) = w;
                }
                if (slot >= 0) { ss += __shfl_xor(ss, 16); ss += __shfl_xor(ss, 32); if (fq == 0) ssqp[(size_t)row * 16 + slot] = ss; }
            }
    }
};
struct EpiScaleRope {
    static constexpr bool PERM = true;
    bf16_t* O; int ldc; const float* ssqp; int nparts4; float inv_n; const float* tabm; int rope_tile0;
    __device__ __forceinline__ void operator()(AccT acc, const pg8::Unit& u, int wr, int wc, int fr, int fq) const {
        const int row0 = u.pm * 256 + wr * 64 + fr, col0 = u.pn * 256 + wc * 32 + 8 * fq;
        const bool rp = u.pn >= rope_tile0;
#pragma unroll
        for (int ai = 0; ai < 2; ++ai)
#pragma unroll
            for (int m = 0; m < 4; ++m) {
                const int row = row0 + ai * 128 + m * 16; bf16_t* rowp = O + (size_t)row * ldc + col0;
                float sq; { const f32x4 a = *(const f32x4*)(ssqp + (size_t)row * 16); sq = (a[0] + a[1]) + (a[2] + a[3]); if (nparts4 > 1) { const f32x4 b = *(const f32x4*)(ssqp + (size_t)row * 16 + 4); sq += (b[0] + b[1]) + (b[2] + b[3]); } }
                const float rs = 1.f / sqrtf(sq * inv_n + NORM_EPS);
#pragma unroll
                for (int bj = 0; bj < 2; ++bj) {
                    f32x4 v0 = acc[ai][bj][m][0] * rs, v1 = acc[ai][bj][m][1] * rs;
                    if (rp) rope4(v0, v1, tabm + (size_t)row * 64 + (16 * (wc & 1) + 4 * fq) * 2);
                    u32x4 w; w.x = cvt_pk_bf16(v0[0], v0[1]); w.y = cvt_pk_bf16(v0[2], v0[3]); w.z = cvt_pk_bf16(v1[0], v1[1]); w.w = cvt_pk_bf16(v1[2], v1[3]);
                    *(u32x4*)(rowp + bj * 128) = w;
                }
            }
    }
};
struct EpiGate {
    static constexpr bool PERM = true;
    const bf16_t* PROJ; const float* conv_w; const float* conv_b; const float* gbr; const float* gbi; const float* spl; float* Aout; float* Bout;
    __device__ __forceinline__ void operator()(AccT acc, const pg8::Unit& u, int wr, int wc, int fr, int fq) const {
        const int row0 = u.pm * 256 + wr * 64 + fr;
#pragma unroll
        for (int n = 0; n < 2; ++n) {
            const int cb = u.pn * 128 + wc * 32 + 8 * fq + 4 * n;
            const f32x4 cw0 = *(const f32x4*)(conv_w + cb), cw1 = *(const f32x4*)(conv_w + 768 + cb), cw2 = *(const f32x4*)(conv_w + 1536 + cb), cw3 = *(const f32x4*)(conv_w + 2304 + cb);
            const f32x4 cbias = *(const f32x4*)(conv_b + cb), br = *(const f32x4*)(gbr + cb), bi = *(const f32x4*)(gbi + cb), sp = *(const f32x4*)(spl + cb);
#pragma unroll
            for (int ai = 0; ai < 2; ++ai)
#pragma unroll
                for (int m = 0; m < 4; ++m) {
                    const int row = row0 + ai * 128 + m * 16;
                    const bf16_t* xp = PROJ + (ptrdiff_t)(row - 3) * NPROJ + cb;
                    const u32x2 x0 = *(const u32x2*)xp, x1 = *(const u32x2*)(xp + NPROJ), x2 = *(const u32x2*)(xp + 2 * NPROJ), x3 = *(const u32x2*)(xp + 3 * NPROJ);
                    const f32x4 rr = acc[ai][0][m][n] + br, ii = acc[ai][1][m][n] + bi;
                    f32x4 av, bv;
#pragma unroll
                    for (int j = 0; j < 4; ++j) {
                        const unsigned w0 = (j < 2 ? x0.x : x0.y), w1 = (j < 2 ? x1.x : x1.y), w2 = (j < 2 ? x2.x : x2.y), w3 = (j < 2 ? x3.x : x3.y);
                        const int sh = (j & 1) ? 16 : 0;
                        const float f0 = bf2f((w0 >> sh) & 0xffffu), f1 = bf2f((w1 >> sh) & 0xffffu), f2 = bf2f((w2 >> sh) & 0xffffu), f3 = bf2f((w3 >> sh) & 0xffffu);
                        const float xc = cbias[j] + cw0[j] * f0 + cw1[j] * f1 + cw2[j] * f2 + cw3[j] * f3;
                        const float r = sigmoidf_(rr[j]), ig = sigmoidf_(ii[j]);
                        const float a = fexp(-sp[j] * r);
                        av[j] = a; bv[j] = sqrtf(fmaxf(1.f - a * a, 0.f)) * ig * xc;
                    }
                    *(f32x4*)(Aout + (size_t)row * 768 + cb) = av; *(f32x4*)(Bout + (size_t)row * 768 + cb) = bv;
                }
        }
    }
};
struct EpiResid {
    static constexpr bool PERM = false;
    const float* Xin; float* Xout;
    __device__ __forceinline__ void operator()(AccT acc, const pg8::Unit& u, int wr, int wc, int fr, int fq) const {
        const int row0 = u.pm * 256 + wr * 64 + fr, col0 = u.pn * 256 + wc * 32 + 4 * fq;
#pragma unroll
        for (int ai = 0; ai < 2; ++ai)
#pragma unroll
            for (int m = 0; m < 4; ++m) { const size_t off = (size_t)(row0 + ai * 128 + m * 16) * DM + col0;
#pragma unroll
                for (int bj = 0; bj < 2; ++bj)
#pragma unroll
                    for (int n = 0; n < 2; ++n) { const f32x4 b = *(const f32x4*)(Xin + off + bj * 128 + n * 16); *(f32x4*)(Xout + off + bj * 128 + n * 16) = b + acc[ai][bj][m][n]; } }
    }
};
struct EpiSwiGLU {
    static constexpr bool PERM = true;
    bf16_t* O;
    __device__ __forceinline__ void operator()(AccT acc, const pg8::Unit& u, int wr, int wc, int fr, int fq) const {
        const int row0 = u.pm * 256 + wr * 64 + fr, col0 = u.pn * 128 + wc * 32 + 8 * fq;
#pragma unroll
        for (int ai = 0; ai < 2; ++ai)
#pragma unroll
            for (int m = 0; m < 4; ++m) {
                bf16_t* rowp = O + (size_t)(row0 + ai * 128 + m * 16) * DFF + col0;
                f32x4 o0, o1;
#pragma unroll
                for (int j = 0; j < 4; ++j) { const float g0 = acc[ai][0][m][0][j], g1 = acc[ai][0][m][1][j];
                    o0[j] = g0 * sigmoidf_(g0) * acc[ai][1][m][0][j]; o1[j] = g1 * sigmoidf_(g1) * acc[ai][1][m][1][j]; }
                u32x4 w; w.x = cvt_pk_bf16(o0[0], o0[1]); w.y = cvt_pk_bf16(o0[2], o0[3]); w.z = cvt_pk_bf16(o1[0], o1[1]); w.w = cvt_pk_bf16(o1[2], o1[3]);
                *(u32x4*)rowp = w;
            }
    }
};

template <int D1, int D2>
__device__ __forceinline__ void attn_run(LAS unsigned char* lds, const bf16_t* Q1, int ldq1, const bf16_t* Q2, int ldq2, const bf16_t* K1, const bf16_t* K2, const bf16_t* V, int ldkv,
                                         int q0, int kt0, int kt1, float c, f32x16 (&O)[4], float& mrun, float& lsum) {
    constexpr int DQK = D1 + D2, NS = DQK / 16, KP = DQK * 2 + 16, VP = 320, KBY = 64 * KP, VBY = 64 * VP, SB = KBY + VBY, KCH = KP / 16, VCH = VP / 16, T = KCH + VCH, NDMAX = (T + 7) / 8;
    static_assert(KBY % 1024 == 0 && 3 * SB <= 139264, "attention LDS ring");
    int tid_ = threadIdx.x; asm volatile("" : "+v"(tid_));
    const int tid = tid_, lane = tid & 63, w = __builtin_amdgcn_readfirstlane(tid >> 6), r = lane & 31, h = lane >> 5;
    bf16x8 qf[NS];
    { const size_t qrow = (size_t)(q0 + 32 * w + r);
#pragma unroll
      for (int s = 0; s < NS; ++s) { if (16 * s < D1) qf[s] = *(const bf16x8*)(Q1 + qrow * ldq1 + 16 * s + 8 * h); else qf[s] = *(const bf16x8*)(Q2 + qrow * ldq2 + (16 * s - D1) + 8 * h); } }
    const int nd = (T - w + 7) / 8;
    const char* dp[NDMAX];
#pragma unroll
    for (int i = 0; i < NDMAX; ++i) {
        const int j = w + 8 * i; const bf16_t* src;
        if (j < KCH) { const int q = 64 * j + lane, row = q / KCH, cc = q % KCH; const int ce = (cc == KCH - 1) ? 0 : cc * 8;
            src = (ce < D1) ? K1 + (size_t)(64 * kt0 + row) * ldkv + ce : K2 + (size_t)(64 * kt0 + row) * ldkv + (ce - D1); }
        else { const int q = 64 * (j - KCH) + lane, row = q / VCH, cc = q % VCH; src = V + (size_t)(64 * kt0 + row) * ldkv + ((cc < 16) ? cc * 8 : 0); }
        dp[i] = (const char*)src;
    }
    const size_t tstep = (size_t)64 * ldkv * 2;
#define ATT_ISSUE(stage) do { _Pragma("unroll") for (int i_ = 0; i_ < NDMAX; ++i_) if (i_ < nd) { \
        __builtin_amdgcn_global_load_lds((const unsigned*)dp[i_], (LAS unsigned*)(lds + (stage) * SB + (w + 8 * i_) * 1024), 16, 0, 0); dp[i_] += tstep; } } while (0)
#define ATT_WAIT(keep_one) do { if (keep_one) { if (nd == NDMAX) asm volatile("s_waitcnt vmcnt(%0)" :: "n"(NDMAX) : "memory"); else asm volatile("s_waitcnt vmcnt(%0)" :: "n"(NDMAX - 1) : "memory"); } \
        else asm volatile("s_waitcnt vmcnt(0)" ::: "memory"); } while (0)
    const int n = kt1 - kt0;
    asm volatile("s_waitcnt vmcnt(0) lgkmcnt(0)" ::: "memory");
    __builtin_amdgcn_s_barrier();
    asm volatile("" ::: "memory");
    ATT_ISSUE(0);
    if (n > 1) ATT_ISSUE(1);
    ATT_WAIT(n > 1);
    __builtin_amdgcn_s_barrier();
    asm volatile("" ::: "memory");
    const int mylast = (q0 >> 6) + (w >> 1);
    float l = 0.f; mrun = -1e30f;
#pragma unroll
    for (int d = 0; d < 4; ++d)
#pragma unroll
        for (int i = 0; i < 16; ++i) O[d][i] = 0.f;
    const int g4 = lane >> 4, li = lane & 15;
    const int vb = KBY + (4 * h + (li >> 2)) * VP + (16 * (g4 & 1) + 4 * (li & 3)) * 2;
    const int kb0 = r * KP + 16 * h;
    const unsigned lds_base = (unsigned)(size_t)lds;
    int stg = 0;
    for (int it = 0; it < n; ++it) {
        const bool ahead = (it + 2 < n);
        if (ahead) { const int s2 = (stg >= 1) ? stg - 1 : 2; ATT_ISSUE(s2); }
        if (kt0 + it <= mylast) {
            const unsigned ka = lds_base + stg * SB + kb0, va = lds_base + stg * SB + vb;
            f32x16 st[2];
#pragma unroll
            for (int kb = 0; kb < 2; ++kb)
#pragma unroll
                for (int i = 0; i < 16; ++i) st[kb][i] = 0.f;
            {
                constexpr int NB = (2 * NS) / 4;
                bf16x8 fa[2][4];
#define K_OFF(idx) (32 * ((idx) / NS) * KP + 32 * ((idx) % NS))
#pragma unroll
                for (int i = 0; i < 4; ++i) asm volatile("ds_read_b128 %0, %1 offset:%2" : "=&v"(fa[0][i]) : "v"(ka), "i"(K_OFF(i)) : "memory");
#pragma unroll
                for (int b = 0; b < NB; ++b) {
                    if (b + 1 < NB) {
#pragma unroll
                        for (int i = 0; i < 4; ++i) asm volatile("ds_read_b128 %0, %1 offset:%2" : "=&v"(fa[(b + 1) & 1][i]) : "v"(ka), "i"(K_OFF(4 * (b + 1) + i)) : "memory");
                        asm volatile("s_waitcnt lgkmcnt(4)" : "+v"(fa[b & 1][0]), "+v"(fa[b & 1][1]), "+v"(fa[b & 1][2]), "+v"(fa[b & 1][3]) :: "memory");
                    } else asm volatile("s_waitcnt lgkmcnt(0)" : "+v"(fa[b & 1][0]), "+v"(fa[b & 1][1]), "+v"(fa[b & 1][2]), "+v"(fa[b & 1][3]) :: "memory");
#pragma unroll
                    for (int i = 0; i < 4; ++i) { constexpr int dummy = 0; (void)dummy; const int idx = 4 * b + i; st[idx / NS] = __builtin_amdgcn_mfma_f32_32x32x16_bf16(fa[b & 1][i], qf[idx % NS], st[idx / NS], 0, 0, 0); }
                }
#undef K_OFF
            }
            float mx = fmaxf(fmaxf(st[0][0], st[0][1]), fmaxf(st[1][0], st[1][1]));
#pragma unroll
            for (int i = 2; i < 16; i += 2) mx = fmaxf(mx, fmaxf(fmaxf(st[0][i], st[0][i + 1]), fmaxf(st[1][i], st[1][i + 1])));
            { const auto rr = __builtin_amdgcn_permlane32_swap(__float_as_uint(mx), __float_as_uint(mx), false, false); mx = fmaxf(__uint_as_float(rr[0]), __uint_as_float(rr[1])); }
            const float mnew = fmaxf(mrun, mx), alpha = __builtin_amdgcn_exp2f((mrun - mnew) * c), mc = mnew * c; mrun = mnew;
            float ps = 0.f;
#pragma unroll
            for (int kb = 0; kb < 2; ++kb)
#pragma unroll
                for (int i = 0; i < 16; ++i) { const float p = __builtin_amdgcn_exp2f(st[kb][i] * c - mc); st[kb][i] = p; ps += p; }
            l = l * alpha + ps;
#pragma unroll
            for (int d = 0; d < 4; ++d) O[d] = O[d] * alpha;
            bf16x8 pf[2][2];
#pragma unroll
            for (int kb = 0; kb < 2; ++kb)
#pragma unroll
                for (int sp = 0; sp < 2; ++sp) { u32x4 t; t.x = cvt_pk_bf16(st[kb][8 * sp + 0], st[kb][8 * sp + 1]); t.y = cvt_pk_bf16(st[kb][8 * sp + 2], st[kb][8 * sp + 3]);
                    t.z = cvt_pk_bf16(st[kb][8 * sp + 4], st[kb][8 * sp + 5]); t.w = cvt_pk_bf16(st[kb][8 * sp + 6], st[kb][8 * sp + 7]); pf[kb][sp] = __builtin_bit_cast(bf16x8, t); }
            {
                s16x4 vl[2][4], vh[2][4];
#define V_OFF(d, f) ((32 * ((f) >> 1) + 16 * ((f) & 1)) * VP + 64 * (d))
#pragma unroll
                for (int f = 0; f < 4; ++f) { asm volatile("ds_read_b64_tr_b16 %0, %1 offset:%2" : "=&v"(vl[0][f]) : "v"(va), "i"(V_OFF(0, f)) : "memory");
                                              asm volatile("ds_read_b64_tr_b16 %0, %1 offset:%2" : "=&v"(vh[0][f]) : "v"(va), "i"(V_OFF(0, f) + 8 * VP) : "memory"); }
#pragma unroll
                for (int d = 0; d < 4; ++d) {
                    if (d + 1 < 4) {
#pragma unroll
                        for (int f = 0; f < 4; ++f) { asm volatile("ds_read_b64_tr_b16 %0, %1 offset:%2" : "=&v"(vl[(d + 1) & 1][f]) : "v"(va), "i"(V_OFF(d + 1, f)) : "memory");
                                                      asm volatile("ds_read_b64_tr_b16 %0, %1 offset:%2" : "=&v"(vh[(d + 1) & 1][f]) : "v"(va), "i"(V_OFF(d + 1, f) + 8 * VP) : "memory"); }
                        asm volatile("s_waitcnt lgkmcnt(8)" : "+v"(vl[d & 1][0]), "+v"(vl[d & 1][1]), "+v"(vl[d & 1][2]), "+v"(vl[d & 1][3]), "+v"(vh[d & 1][0]), "+v"(vh[d & 1][1]), "+v"(vh[d & 1][2]), "+v"(vh[d & 1][3]) :: "memory");
                    } else asm volatile("s_waitcnt lgkmcnt(0)" : "+v"(vl[d & 1][0]), "+v"(vl[d & 1][1]), "+v"(vl[d & 1][2]), "+v"(vl[d & 1][3]), "+v"(vh[d & 1][0]), "+v"(vh[d & 1][1]), "+v"(vh[d & 1][2]), "+v"(vh[d & 1][3]) :: "memory");
#pragma unroll
                    for (int f = 0; f < 4; ++f) { const s16x4 lo = vl[d & 1][f], hi = vh[d & 1][f];
                        const bf16x8 vf = (bf16x8){lo[0], lo[1], lo[2], lo[3], hi[0], hi[1], hi[2], hi[3]};
                        O[d] = __builtin_amdgcn_mfma_f32_32x32x16_bf16(vf, pf[f >> 1][f & 1], O[d], 0, 0, 0); }
                }
#undef V_OFF
            }
        }
        ATT_WAIT(ahead);
        __builtin_amdgcn_s_barrier();
        asm volatile("" ::: "memory");
        stg = (stg == 2) ? 0 : stg + 1;
    }
#undef ATT_ISSUE
#undef ATT_WAIT
    lsum = l + __shfl_xor(l, 32);
}

struct AttnArgs { const bf16_t* PROJ; const bf16_t* Qb; const bf16_t* KVb; bf16_t* MIX; float* stash; float* part_o; float* part_ml; const float* g_sub; float lam; float one_m_linit; };
constexpr float C_DIFF = 0.125f * 1.4426950408889634f, C_MLA = 0.07216878364870322f * 1.4426950408889634f;

__device__ __forceinline__ void attn_store_part(const AttnArgs& a, int pi, size_t qrow, int h, const f32x16 (&O)[4], float mrun, float lsum) {
    float* po = a.part_o + ((size_t)pi * 4096 + (qrow - 4096)) * 128;
#pragma unroll
    for (int d = 0; d < 4; ++d)
#pragma unroll
        for (int g = 0; g < 4; ++g) { f32x4 v = {O[d][4 * g], O[d][4 * g + 1], O[d][4 * g + 2], O[d][4 * g + 3]}; *(f32x4*)(po + 32 * d + 8 * g + 4 * h) = v; }
    if (h == 0) { f32x2 ml = {mrun, lsum}; *(f32x2*)(a.part_ml + ((size_t)pi * 4096 + (qrow - 4096)) * 2) = ml; }
}
__device__ __forceinline__ void attn_unit_diff_part(LAS unsigned char* lds, const AttnArgs& a, int hd, int map, int qb, int part) {
    int tid_ = threadIdx.x; asm volatile("" : "+v"(tid_));
    const int tid = tid_, lane = tid & 63, w = tid >> 6, r = lane & 31, h = lane >> 5;
    const int q0 = 256 * qb, nt = 4 * qb + 4, kt0 = part ? nt / 2 : 0, kt1 = part ? nt : nt / 2; const size_t qrow = (size_t)(q0 + 32 * w + r);
    f32x16 O[4]; float mrun, lsum;
    attn_run<64, 0>(lds, a.PROJ + 1536 + 128 * hd + 64 * map, NPROJ, nullptr, 0, a.PROJ + 2048 + 128 * hd + 64 * map, nullptr, a.PROJ + 2560 + 128 * hd, NPROJ, q0, kt0, kt1, C_DIFF, O, mrun, lsum);
    attn_store_part(a, (hd * 2 + map) * 2 + part, qrow, h, O, mrun, lsum);
}
__device__ __forceinline__ void attn_unit_mla_part(LAS unsigned char* lds, const AttnArgs& a, int hh, int qb, int part) {
    int tid_ = threadIdx.x; asm volatile("" : "+v"(tid_));
    const int tid = tid_, lane = tid & 63, w = tid >> 6, r = lane & 31, h = lane >> 5;
    const int q0 = 256 * qb, nt = 4 * qb + 4, kt0 = part ? nt / 2 : 0, kt1 = part ? nt : nt / 2; const size_t qrow = (size_t)(q0 + 32 * w + r);
    f32x16 O[4]; float mrun, lsum;
    attn_run<128, 64>(lds, a.Qb + 128 * hh, NQ, a.Qb + 768 + 64 * hh, NQ, a.KVb + 128 * hh, a.KVb + 1536, a.KVb + 768 + 128 * hh, NKVP, q0, kt0, kt1, C_MLA, O, mrun, lsum);
    attn_store_part(a, (8 + hh) * 2 + part, qrow, h, O, mrun, lsum);
}
__device__ __forceinline__ void attn_unit_diff(LAS unsigned char* lds, const AttnArgs& a, int hd, int qb) {
    int tid_ = threadIdx.x; asm volatile("" : "+v"(tid_));
    const int tid = tid_, lane = tid & 63, w = tid >> 6, r = lane & 31, h = lane >> 5;
    const int q0 = 256 * qb, nt = 4 * qb + 4; const size_t qrow = (size_t)(q0 + 32 * w + r);
    f32x16 O[4]; float mrun, lsum;
    float* st = a.stash + ((size_t)hd * S + qrow) * 128;
    const bf16_t* Vp = a.PROJ + 2560 + 128 * hd;
    attn_run<64, 0>(lds, a.PROJ + 1536 + 128 * hd, NPROJ, nullptr, 0, a.PROJ + 2048 + 128 * hd, nullptr, Vp, NPROJ, q0, 0, nt, C_DIFF, O, mrun, lsum);
    { const float linv = 1.f / lsum;
#pragma unroll
      for (int d = 0; d < 4; ++d)
#pragma unroll
        for (int g = 0; g < 4; ++g) { f32x4 v = {O[d][4 * g] * linv, O[d][4 * g + 1] * linv, O[d][4 * g + 2] * linv, O[d][4 * g + 3] * linv}; *(f32x4*)(st + 32 * d + 8 * g + 4 * h) = v; } }
    attn_run<64, 0>(lds, a.PROJ + 1536 + 128 * hd + 64, NPROJ, nullptr, 0, a.PROJ + 2048 + 128 * hd + 64, nullptr, Vp, NPROJ, q0, 0, nt, C_DIFF, O, mrun, lsum);
    float ss = 0.f; const float ll = a.lam / lsum;
#pragma unroll
    for (int d = 0; d < 4; ++d)
#pragma unroll
        for (int g = 0; g < 4; ++g) { const f32x4 s1 = *(const f32x4*)(st + 32 * d + 8 * g + 4 * h);
#pragma unroll
            for (int j = 0; j < 4; ++j) { const float o = s1[j] - ll * O[d][4 * g + j]; O[d][4 * g + j] = o; ss += o * o; } }
    ss += __shfl_xor(ss, 32);
    const float rs = a.one_m_linit / sqrtf(ss * (1.f / 128.f) + SUBLN_EPS);
    bf16_t* op = a.MIX + qrow * DM + 768 + 128 * hd;
#pragma unroll
    for (int d = 0; d < 4; ++d)
#pragma unroll
        for (int g = 0; g < 4; ++g) { const int dv = 32 * d + 8 * g + 4 * h; const f32x4 gs = *(const f32x4*)(a.g_sub + dv);
            u32x2 o; o.x = cvt_pk_bf16(O[d][4 * g] * rs * gs[0], O[d][4 * g + 1] * rs * gs[1]); o.y = cvt_pk_bf16(O[d][4 * g + 2] * rs * gs[2], O[d][4 * g + 3] * rs * gs[3]);
            *(u32x2*)(op + dv) = o; }
}
__device__ __forceinline__ void attn_unit_mla(LAS unsigned char* lds, const AttnArgs& a, int hh, int qb) {
    int tid_ = threadIdx.x; asm volatile("" : "+v"(tid_));
    const int tid = tid_, lane = tid & 63, w = tid >> 6, r = lane & 31, h = lane >> 5;
    const int q0 = 256 * qb, nt = 4 * qb + 4; const size_t qrow = (size_t)(q0 + 32 * w + r);
    f32x16 O[4]; float mrun, lsum;
    attn_run<128, 64>(lds, a.Qb + 128 * hh, NQ, a.Qb + 768 + 64 * hh, NQ, a.KVb + 128 * hh, a.KVb + 1536, a.KVb + 768 + 128 * hh, NKVP, q0, 0, nt, C_MLA, O, mrun, lsum);
    const float linv = 1.f / lsum;
    bf16_t* op = a.MIX + qrow * DM + 1280 + 128 * hh;
#pragma unroll
    for (int d = 0; d < 4; ++d)
#pragma unroll
        for (int g = 0; g < 4; ++g) { const int dv = 32 * d + 8 * g + 4 * h;
            u32x2 o; o.x = cvt_pk_bf16(O[d][4 * g] * linv, O[d][4 * g + 1] * linv); o.y = cvt_pk_bf16(O[d][4 * g + 2] * linv, O[d][4 * g + 3] * linv);
            *(u32x2*)(op + dv) = o; }
}
constexpr int N_ATT_UNITS = 608, SCHED_SLOTS = 5;
__device__ __forceinline__ void attn_dispatch(LAS unsigned char* lds, const AttnArgs& a, int u) {
    if (u < 64) attn_unit_diff(lds, a, u & 3, u >> 2);
    else if (u < 160) { const int v = u - 64; attn_unit_mla(lds, a, v % 6, v / 6); }
    else if (u < 416) { const int v = u - 160; attn_unit_diff_part(lds, a, (v >> 2) & 3, (v >> 1) & 1, 16 + (v >> 4), v & 1); }
    else { const int v = u - 416; attn_unit_mla_part(lds, a, (v >> 1) % 6, 16 + (v >> 1) / 6, v & 1); }
}

template <class F>
__device__ __forceinline__ void conv_mat(const F f, bf16_t* WT, int N, int K, LAS float* scr, int gw, int NGW, int lane) {
    const int nblk = N / 32, nitems = (K / 64) * nblk;
    for (int it = gw; it < nitems; it += NGW) {
        const int kb = it / nblk, nb = it % nblk, k0 = 64 * kb, n0 = 32 * nb;
        float v[32];
#pragma unroll
        for (int i = 0; i < 32; ++i) v[i] = f(k0 + 2 * i + (lane >> 5), n0 + (lane & 31));
#pragma unroll
        for (int i = 0; i < 32; ++i) scr[(2 * i + (lane >> 5)) * 33 + (lane & 31)] = v[i];
        asm volatile("s_waitcnt lgkmcnt(0)" ::: "memory");
        const int c = lane & 7;
#pragma unroll
        for (int j = 0; j < 4; ++j) { const int n = (lane >> 3) + 8 * j; const LAS float* s = scr + (8 * c) * 33 + n;
            u32x4 o; o.x = pk2(s[0 * 33], s[1 * 33]); o.y = pk2(s[2 * 33], s[3 * 33]); o.z = pk2(s[4 * 33], s[5 * 33]); o.w = pk2(s[6 * 33], s[7 * 33]);
            *(u32x4*)(WT + (size_t)(n0 + n) * K + k0 + 8 * c) = o; }
        asm volatile("s_waitcnt lgkmcnt(0)" ::: "memory");
    }
}
struct FPlain { const float* W; int N; __device__ __forceinline__ float operator()(int k, int n) const { return W[(size_t)k * N + n]; } };
struct FWin { const float* W; __device__ __forceinline__ float operator()(int k, int n) const {
    int src = n;
    if (n >= 1536 && n < 2560) { const int p = n & 63; if (p < 16) src = (n & ~63) + ((p & 1) ? 8 + (p >> 1) : (p >> 1)); }
    else if (n >= 3840) { const int p = n - 3840; if (p >= 64) return 0.f; src = 3840 + ((p & 1) ? 32 + (p >> 1) : (p >> 1)); }
    return W[(size_t)k * 3904 + src]; } };
struct FQb { const float* W; const float* g; __device__ __forceinline__ float operator()(int k, int n) const {
    if (n >= 1152) return 0.f; int src;
    if (n < 768) src = 192 * (n >> 7) + (n & 127); else { const int hh = (n - 768) >> 6, p = (n - 768) & 63; src = 192 * hh + 128 + ((p & 1) ? 32 + (p >> 1) : (p >> 1)); }
    return W[(size_t)k * 1152 + src] * g[k]; } };
struct FKVb { const float* W; const float* g; __device__ __forceinline__ float operator()(int k, int n) const {
    int src; if (n < 768) src = 256 * (n >> 7) + (n & 127); else src = 256 * ((n - 768) >> 7) + 128 + ((n - 768) & 127);
    return W[(size_t)k * 1536 + src] * g[k]; } };
struct FGate { const float* cw; const float* wr; const float* wi; __device__ __forceinline__ float operator()(int kk, int n) const {
    const int j = kk >> 7, k = kk & 127, hb = n >> 8, isI = (n >> 7) & 1, c = n & 127;
    const ptrdiff_t d = (const char*)wi - (const char*)wr; const float* wsel = (const float*)((const char*)wr + (isI ? d : (ptrdiff_t)0));
    return cw[j * 768 + 128 * hb + k] * wsel[((size_t)hb * 128 + k) * 128 + c]; } };
struct FGU { const float* wg; const float* wu; __device__ __forceinline__ float operator()(int k, int n) const {
    const int t = n >> 8, rr = n & 255, src = 128 * t + (rr & 127); const ptrdiff_t d = (const char*)wu - (const char*)wg; const float* wsel = (const float*)((const char*)wg + (rr < 128 ? (ptrdiff_t)0 : d));
    return wsel[(size_t)k * DFF + src]; } };


#define XB_TMO      128
#define XB_XCNT(j)  (256  + 64 * (j))
#define XB_XSUB(j)  (1280 + 64 * (j))
#define XB_XGEN(j)  (2304 + 64 * (j))
#define XB_TOP      3328
#define XB_TOPGEN   3392
#define XCD_BAR_WORDS 3456
#define XB_SPIN_CAP (1u << 22)
__device__ __forceinline__ unsigned xb_ld(unsigned* p)              { return __hip_atomic_load(p, __ATOMIC_RELAXED, __HIP_MEMORY_SCOPE_AGENT); }
__device__ __forceinline__ unsigned xb_add(unsigned* p, unsigned v) { return __hip_atomic_fetch_add(p, v, __ATOMIC_RELAXED, __HIP_MEMORY_SCOPE_AGENT); }
__device__ __forceinline__ unsigned xb_xcc_id() { return (unsigned)__builtin_amdgcn_s_getreg((3 << 11) | 20) & 0xFu; }
#define XB_SPIN(cond, bar) do { unsigned _sp = 0; while (cond) { __builtin_amdgcn_s_sleep(1); \
    if ((++_sp & 255u) == 0u) { if (xb_ld(&(bar)[XB_TMO])) break; if (_sp > XB_SPIN_CAP) { atomicAdd(&(bar)[XB_TMO], 1u); break; } } } } while (0)
struct XcdBarrier { unsigned* bar; unsigned x; volatile LAS unsigned* st; };
__device__ __forceinline__ XcdBarrier xcd_barrier_post(unsigned* bar, volatile LAS unsigned* st) {
    XcdBarrier b; b.bar = bar; b.x = xb_xcc_id(); b.st = st;
    if (threadIdx.x == 0) (void)xb_add(&bar[XB_XCNT(b.x)], 1u);
    return b;
}
__device__ __forceinline__ void xcd_barrier_complete(unsigned* bar, unsigned x, unsigned& nloc, unsigned& nx) {
    const unsigned G = gridDim.x * gridDim.y * gridDim.z;
    unsigned sum, cnt, mine, sp = 0u;
    for (;;) {
        sum = 0u; cnt = 0u; mine = 0u;
#pragma unroll
        for (unsigned j = 0; j < 16; ++j) { const unsigned c = xb_ld(&bar[XB_XCNT(j)]); sum += c; cnt += (c > 0u) ? 1u : 0u; mine = (j == x) ? c : mine; }
        if (sum == G) break;
        __builtin_amdgcn_s_sleep(1);
        if ((++sp & 255u) == 0u) { if (xb_ld(&bar[XB_TMO])) break; if (sp > XB_SPIN_CAP) { atomicAdd(&bar[XB_TMO], 1u); break; } }
    }
    nloc = mine > 0u ? mine : 1u; nx = cnt > 0u ? cnt : 1u;
}
__device__ __forceinline__ void xcd_barrier(unsigned* bar, volatile LAS unsigned* st) {
    asm volatile("s_waitcnt vmcnt(0)" ::: "memory");
    __syncthreads();
    if (threadIdx.x == 0) {
        const unsigned x = xb_xcc_id();
        __builtin_amdgcn_s_waitcnt(0);
        unsigned nloc = st[0], nx = st[1];
        if (nloc == 0u) { xcd_barrier_complete(bar, x, nloc, nx); st[0] = nloc; st[1] = nx; }
        const unsigned old = xb_add(&bar[XB_XSUB(x)], 1u);
        const unsigned gen = old / nloc;
        if (old + 1u == (gen + 1u) * nloc) {
            __builtin_amdgcn_fence(__ATOMIC_RELEASE, "agent");
            asm volatile("s_waitcnt vmcnt(0)" ::: "memory");
            const unsigned og = xb_add(&bar[XB_TOP], 1u);
            const unsigned tg = og / nx;
            if (og + 1u == (tg + 1u) * nx) xb_add(&bar[XB_TOPGEN], 1u);
            else XB_SPIN(xb_ld(&bar[XB_TOPGEN]) == tg, bar);
            __builtin_amdgcn_fence(__ATOMIC_ACQUIRE, "agent");
            xb_add(&bar[XB_XGEN(x)], 1u);
            asm volatile("s_waitcnt vmcnt(0)" ::: "memory");
        } else {
            XB_SPIN(xb_ld(&bar[XB_XGEN(x)]) == gen, bar);
            __builtin_amdgcn_fence(__ATOMIC_ACQUIRE, "agent");
            asm volatile("s_waitcnt vmcnt(0)" ::: "memory");
        }
    }
    __syncthreads();
}
struct Params {
    const float* x; const int* pos; const float *g_mix, *w_in, *conv_w, *conv_b, *w_r, *b_r, *w_i, *b_i, *lru_lambda, *lam_q1, *lam_k1, *lam_q2, *lam_k2, *g_sub, *g_q_a, *w_q_b, *g_kv_a, *w_kv_b,
        *w_out, *g_ffn, *w_gate, *w_up, *w_down, *g_final;
    float* out; unsigned char* ws;
    short order[N_ATT_UNITS];
};

__device__ __forceinline__ void norm_rows(const float* X, const float* g, bf16_t* ob, float* of, int gw, int NGW, int lane) {
    for (int row = gw; row < S; row += NGW) {
        const f32x4* xr = (const f32x4*)(X + (size_t)row * DM) + lane;
        f32x4 v[8]; float ss = 0.f;
#pragma unroll
        for (int j = 0; j < 8; ++j) { v[j] = xr[64 * j]; ss += (v[j][0] * v[j][0] + v[j][1] * v[j][1]) + (v[j][2] * v[j][2] + v[j][3] * v[j][3]); }
        const float rstd = 1.f / sqrtf(wave_sum(ss) * (1.f / DM) + NORM_EPS);
#pragma unroll
        for (int j = 0; j < 8; ++j) { const f32x4 gg = ((const f32x4*)g)[lane + 64 * j]; const f32x4 o = v[j] * rstd * gg;
            if (of) ((f32x4*)(of + (size_t)row * DM))[lane + 64 * j] = o;
            else { u32x2 w; w.x = pk2(o[0], o[1]); w.y = pk2(o[2], o[3]); ((u32x2*)(ob + (size_t)row * DM))[lane + 64 * j] = w; } }
    }
}

typedef const __attribute__((address_space(4))) Params* KParams;
__device__ __forceinline__ KParams kparams() { auto kp = __builtin_amdgcn_kernarg_segment_ptr(); asm volatile("" : "+s"(kp)); return (KParams)kp; }
__device__ __forceinline__ int otid() { int t = threadIdx.x; asm volatile("" : "+v"(t)); return t; }
#define WSP(T, off) ((T*)(ws + (off)))
#define GSYNC() do { asm volatile("s_waitcnt vmcnt(0) lgkmcnt(0)" ::: "memory"); grid.sync(); __builtin_amdgcn_fence(__ATOMIC_ACQUIRE, "agent"); asm volatile("s_waitcnt vmcnt(0)" ::: "memory"); } while (0)

__global__ void __launch_bounds__(512, 2) mega_fwd(Params p_unused) {
    extern __shared__ __attribute__((aligned(16))) unsigned char lds_raw[];
    LAS unsigned char* lds = (LAS unsigned char*)lds_raw;
    cg::grid_group grid = cg::this_grid();
    volatile LAS unsigned* bst = (volatile LAS unsigned*)(lds + LDS_BYTES - 64);
    if (threadIdx.x < 2) bst[threadIdx.x] = 0u;
    __syncthreads();
    { KParams P = kparams(); (void)xcd_barrier_post((unsigned*)(P->ws + WS_BAR), bst); }
#define XSYNC() do { KParams P_ = kparams(); xcd_barrier((unsigned*)(P_->ws + WS_BAR), bst); } while (0)

    {
        KParams P = kparams(); unsigned char* ws = P->ws;
        const int tid = otid(), lane = tid & 63, wave = __builtin_amdgcn_readfirstlane(tid >> 6);
        const int G = gridDim.x, bx = blockIdx.x, gw = bx * 8 + wave, NGW = G * 8, gt = bx * 512 + tid, NT = G * 512;
        float* GBR = WSP(float, WS_GB); float* GBI = GBR + DEPTH * 768; float* SPL = GBI + DEPTH * 768;
        float* TABD = WSP(float, WS_TABD); float* TABM = WSP(float, WS_TABM);
        for (int i = gt; i < (int)(PROJ_PAD / 4); i += NT) WSP(unsigned, WS_PROJ0)[i] = 0u;
        const int* pos = P->pos;
        for (int i = gt; i < S * 40; i += NT) {
            const int t = i / 40, e = i % 40; const bool dd = e < 8; const int fi = dd ? e : e - 8; const float half = dd ? 8.f : 32.f;
            const float inv = exp2f(-(float)fi / half * 18.931568569324174f);
            const float ang = (float)pos[t] * inv;
            const double rev = (double)ang * 0.15915494309189535; const float fr = (float)(rev - rint(rev));
            const float cs = __builtin_amdgcn_cosf(fr), sn = __builtin_amdgcn_sinf(fr);
            float* dst = dd ? TABD + ((size_t)t * 8 + fi) * 2 : TABM + ((size_t)t * 32 + fi) * 2; dst[0] = cs; dst[1] = sn;
        }
        {
            const float* b_r = P->b_r; const float* b_i = P->b_i; const float* w_r = P->w_r; const float* w_i = P->w_i; const float* conv_b = P->conv_b; const float* lam = P->lru_lambda;
            for (int o = gw; o < DEPTH * 768; o += NGW) {
                const int l = o / 768, cch = o % 768, hb = cch >> 7, cc = cch & 127;
                const float* wr_ = w_r + ((size_t)l * 6 + hb) * 128 * 128 + cc; const float* wi_ = w_i + ((size_t)l * 6 + hb) * 128 * 128 + cc; const float* cb = conv_b + l * 768 + hb * 128;
                float sr = 0.f, si = 0.f;
#pragma unroll
                for (int k = lane; k < 128; k += 64) { const float cv = cb[k]; sr += cv * wr_[k * 128]; si += cv * wi_[k * 128]; }
                sr = wave_sum(sr); si = wave_sum(si);
                if (lane == 0) { GBR[o] = sr + b_r[o]; GBI[o] = si + b_i[o]; SPL[o] = 8.f * log1pf(expf(-lam[o])); }
            }
        }
        LAS float* scr = (LAS float*)(lds + wave * 8448);
#pragma unroll 1
        for (int l = 0; l < DEPTH; ++l) {
            unsigned char* wb = ws + WS_W + (size_t)l * LAYER_W;
            conv_mat(FWin{P->w_in + (size_t)l * DM * 3904}, (bf16_t*)(wb + W_WIN), NPROJ, DM, scr, gw, NGW, lane);
            conv_mat(FQb{P->w_q_b + (size_t)l * 512 * 1152, P->g_q_a + l * 512}, (bf16_t*)(wb + W_WQB), NQ, 512, scr, (gw + 517) % NGW, NGW, lane);
            conv_mat(FKVb{P->w_kv_b + (size_t)l * 256 * 1536, P->g_kv_a + l * 256}, (bf16_t*)(wb + W_WKVB), NKV, 256, scr, (gw + 837) % NGW, NGW, lane);
            conv_mat(FGate{P->conv_w + (size_t)l * 4 * 768, P->w_r + (size_t)l * 6 * 128 * 128, P->w_i + (size_t)l * 6 * 128 * 128}, (bf16_t*)(wb + W_WG), 1536, 512, scr, (gw + 1029) % NGW, NGW, lane);
            conv_mat(FPlain{P->w_out + (size_t)l * DM * DM, DM}, (bf16_t*)(wb + W_WOUT), DM, DM, scr, (gw + 1413) % NGW, NGW, lane);
            conv_mat(FGU{P->w_gate + (size_t)l * DM * DFF, P->w_up + (size_t)l * DM * DFF}, (bf16_t*)(wb + W_WGU), NGU, DM, scr, gw, NGW, lane);
            conv_mat(FPlain{P->w_down + (size_t)l * DFF * DM, DM}, (bf16_t*)(wb + W_WDOWN), DM, DFF, scr, gw, NGW, lane);
        }
    }
    GSYNC();

#pragma unroll 1
    for (int l = 0; l < DEPTH; ++l) {
        { KParams P = kparams(); unsigned char* ws = P->ws; const int tid = otid(), lane = tid & 63, wave = __builtin_amdgcn_readfirstlane(tid >> 6);
          norm_rows((l == 0) ? P->x : WSP(const float, WS_X), P->g_mix + l * DM, WSP(bf16_t, WS_HN), nullptr, blockIdx.x * 8 + wave, gridDim.x * 8, lane); }
        XSYNC();
        { KParams P = kparams(); unsigned char* ws = P->ws; unsigned char* wb = ws + WS_W + (size_t)l * LAYER_W;
          pg8::Gemm g{WSP(const bf16_t, WS_HN), (const bf16_t*)(wb + W_WIN), DM, DM, 0}; pg8::StaticOrder so; so.init(S, NPROJ, gridDim.x, blockIdx.x);
          EpiProj E{WSP(bf16_t, WS_PROJ0 + PROJ_PAD), WSP(const float, WS_TABD), WSP(const float, WS_TABM), WSP(float, WS_SSQ), WSP(bf16_t, WS_KV)}; pg8::gemm_phase<EpiProj, false>(lds, g, so, E); }
        XSYNC();
        { KParams P = kparams(); unsigned char* ws = P->ws; unsigned char* wb = ws + WS_W + (size_t)l * LAYER_W;
          pg8::Gemm g{WSP(const bf16_t, WS_PROJ0 + PROJ_PAD) + 3072, (const bf16_t*)(wb + W_WQB), NPROJ, 512, 0}; pg8::StaticOrder so; so.init(S, NQ, gridDim.x, blockIdx.x);
          EpiScaleRope E{WSP(bf16_t, WS_Q), NQ, WSP(const float, WS_SSQ), 2, 1.f / 512.f, WSP(const float, WS_TABM), 3}; pg8::gemm_phase<EpiScaleRope, false>(lds, g, so, E); }
        { KParams P = kparams(); unsigned char* ws = P->ws; unsigned char* wb = ws + WS_W + (size_t)l * LAYER_W;
          pg8::Gemm g{WSP(const bf16_t, WS_PROJ0 + PROJ_PAD) + 3584, (const bf16_t*)(wb + W_WKVB), NPROJ, 256, 0}; pg8::StaticOrder so; so.init(S, NKV, gridDim.x, (blockIdx.x + 96) % gridDim.x);
          EpiScaleRope E{WSP(bf16_t, WS_KV), NKVP, WSP(const float, WS_SSQ) + 8, 1, 1.f / 256.f, WSP(const float, WS_TABM), 1000}; pg8::gemm_phase<EpiScaleRope, false>(lds, g, so, E); }
        { KParams P = kparams(); unsigned char* ws = P->ws; unsigned char* wb = ws + WS_W + (size_t)l * LAYER_W; const bf16_t* PROJ = WSP(const bf16_t, WS_PROJ0 + PROJ_PAD);
          float* GBR = WSP(float, WS_GB);
          pg8::Gemm g{PROJ, (const bf16_t*)(wb + W_WG), NPROJ, 512, 256}; pg8::StaticOrder so; so.init(S, 1536, gridDim.x, (blockIdx.x + 160) % gridDim.x);
          EpiGate E{PROJ, P->conv_w + (size_t)l * 4 * 768, P->conv_b + l * 768, GBR + l * 768, GBR + (DEPTH + l) * 768, GBR + (2 * DEPTH + l) * 768, WSP(float, WS_A), WSP(float, WS_B)};
          pg8::gemm_phase<EpiGate, true>(lds, g, so, E); }
        XSYNC();
        { KParams P = kparams(); unsigned char* ws = P->ws; const int tid = otid(); const float* Ab = WSP(const float, WS_A); const float* Bb = WSP(const float, WS_B); float* CP = WSP(float, WS_CP); float* CH = WSP(float, WS_CH);
          for (int it = blockIdx.x; it < 256; it += gridDim.x) {
            if (tid < 384) {
              const int tc = it >> 1, c = 384 * (it & 1) + tid, t0 = 64 * tc;
              float Pp = 1.f, H = 0.f;
#pragma unroll 16
              for (int t = 0; t < 64; ++t) { const float a = Ab[(size_t)(t0 + t) * 768 + c], b = Bb[(size_t)(t0 + t) * 768 + c]; H = a * H + b; Pp *= a; }
              CP[tc * 768 + c] = Pp; CH[tc * 768 + c] = H;
            }
          } }
        { KParams P = kparams(); unsigned char* ws = P->ws; const int tid = otid(), lane = tid & 63;
          const float linit = 0.8f - 0.6f * expf(-0.3f * (float)l);
          const float s1 = wave_sum(P->lam_q1[l * 64 + lane] * P->lam_k1[l * 64 + lane]), s2 = wave_sum(P->lam_q2[l * 64 + lane] * P->lam_k2[l * 64 + lane]);
          AttnArgs a{WSP(const bf16_t, WS_PROJ0 + PROJ_PAD), WSP(const bf16_t, WS_Q), WSP(const bf16_t, WS_KV), WSP(bf16_t, WS_MIX), WSP(float, WS_STASH), WSP(float, WS_PARTO), WSP(float, WS_PARTML),
                     P->g_sub + l * 128, expf(s1) - expf(s2) + linit, 1.f - linit};
          unsigned* qctr = (unsigned*)(ws + WS_BAR) + XCD_BAR_WORDS + 64 * l;
#pragma unroll 1
          for (;;) {
              if (tid == 0) { const unsigned idx = xb_add(qctr, 1u); bst[2] = (idx < (unsigned)N_ATT_UNITS) ? (unsigned)(int)P->order[idx] : 0xffffffffu; }
              __syncthreads();
              const int u = __builtin_amdgcn_readfirstlane((int)bst[2]);
              if (u < 0) break;
              attn_dispatch(lds, a, u);
          } }
        XSYNC();
        { KParams P = kparams(); unsigned char* ws = P->ws; const int tid = otid(); const float* Ab = WSP(const float, WS_A); const float* Bb = WSP(const float, WS_B); const float* CP = WSP(const float, WS_CP); const float* CH = WSP(const float, WS_CH);
          const bf16_t* PROJ = WSP(const bf16_t, WS_PROJ0 + PROJ_PAD); bf16_t* MIX = WSP(bf16_t, WS_MIX);
          for (int it = blockIdx.x; it < 256; it += gridDim.x) {
            if (tid < 384) {
              const int tc = it >> 1, c = 384 * (it & 1) + tid, t0 = 64 * tc;
              float H = 0.f;
#pragma unroll 16
              for (int j = 0; j < tc; ++j) H = CP[j * 768 + c] * H + CH[j * 768 + c];
#pragma unroll 1
              for (int tb = 0; tb < 64; tb += 16) {
                  float av[16], bv[16]; unsigned yv[16];
#pragma unroll
                  for (int t = 0; t < 16; ++t) { av[t] = Ab[(size_t)(t0 + tb + t) * 768 + c]; bv[t] = Bb[(size_t)(t0 + tb + t) * 768 + c]; yv[t] = PROJ[(size_t)(t0 + tb + t) * NPROJ + 768 + c]; }
                  __builtin_amdgcn_sched_barrier(0);
#pragma unroll
                  for (int t = 0; t < 16; ++t) { H = av[t] * H + bv[t]; MIX[(size_t)(t0 + tb + t) * DM + c] = (bf16_t)f2bf(H * gelu_tanh(bf2f(yv[t]))); }
              }
            }
          } }
        { KParams P = kparams(); unsigned char* ws = P->ws; const int tid = otid(), lane = tid & 63, wave = __builtin_amdgcn_readfirstlane(tid >> 6);
          const float linit = 0.8f - 0.6f * expf(-0.3f * (float)l);
          const float s1 = wave_sum(P->lam_q1[l * 64 + lane] * P->lam_k1[l * 64 + lane]), s2 = wave_sum(P->lam_q2[l * 64 + lane] * P->lam_k2[l * 64 + lane]);
          const float lam = expf(s1) - expf(s2) + linit, oml = 1.f - linit;
          const float* PO = WSP(const float, WS_PARTO); const float* PML = WSP(const float, WS_PARTML); bf16_t* MIX = WSP(bf16_t, WS_MIX);
          const f32x2 gs = *(const f32x2*)(P->g_sub + l * 128 + 2 * lane);
          const int NGW = gridDim.x * 8;
#pragma unroll 1
          for (int rr = blockIdx.x * 8 + wave; rr < 4096; rr += NGW) {
              f32x2 ml[28], po[28];
#pragma unroll
              for (int p = 0; p < 28; ++p) { ml[p] = *(const f32x2*)(PML + ((size_t)p * 4096 + rr) * 2); po[p] = *(const f32x2*)(PO + ((size_t)p * 4096 + rr) * 128 + 2 * lane); }
              bf16_t* mrow = MIX + (size_t)(4096 + rr) * DM;
#pragma unroll
              for (int hh = 0; hh < 4; ++hh) {
                  f32x2 om[2];
#pragma unroll
                  for (int m = 0; m < 2; ++m) { const int p0 = (hh * 2 + m) * 2;
                      const float M = fmaxf(ml[p0][0], ml[p0 + 1][0]), w0 = __builtin_amdgcn_exp2f((ml[p0][0] - M) * C_DIFF), w1 = __builtin_amdgcn_exp2f((ml[p0 + 1][0] - M) * C_DIFF);
                      const float inv = 1.f / (w0 * ml[p0][1] + w1 * ml[p0 + 1][1]);
                      om[m] = (po[p0] * w0 + po[p0 + 1] * w1) * inv; }
                  const f32x2 o = om[0] - om[1] * lam;
                  const float ss = wave_sum(o[0] * o[0] + o[1] * o[1]);
                  const float rs = oml / sqrtf(ss * (1.f / 128.f) + SUBLN_EPS);
                  ((unsigned*)(mrow + 768 + 128 * hh))[lane] = pk2(o[0] * rs * gs[0], o[1] * rs * gs[1]);
              }
#pragma unroll
              for (int hh = 0; hh < 6; ++hh) { const int p0 = (8 + hh) * 2;
                  const float M = fmaxf(ml[p0][0], ml[p0 + 1][0]), w0 = __builtin_amdgcn_exp2f((ml[p0][0] - M) * C_MLA), w1 = __builtin_amdgcn_exp2f((ml[p0 + 1][0] - M) * C_MLA);
                  const float inv = 1.f / (w0 * ml[p0][1] + w1 * ml[p0 + 1][1]);
                  const f32x2 o = (po[p0] * w0 + po[p0 + 1] * w1) * inv;
                  ((unsigned*)(mrow + 1280 + 128 * hh))[lane] = pk2(o[0], o[1]);
              }
          } }
        XSYNC();
        { KParams P = kparams(); unsigned char* ws = P->ws; unsigned char* wb = ws + WS_W + (size_t)l * LAYER_W;
          pg8::Gemm g{WSP(const bf16_t, WS_MIX), (const bf16_t*)(wb + W_WOUT), DM, DM, 0}; pg8::StaticOrder so; so.init(S, DM, gridDim.x, blockIdx.x);
          EpiResid E{(l == 0) ? P->x : WSP(const float, WS_X), WSP(float, WS_X)}; pg8::gemm_phase<EpiResid, false>(lds, g, so, E); }
        XSYNC();
        { KParams P = kparams(); unsigned char* ws = P->ws; const int tid = otid(), lane = tid & 63, wave = __builtin_amdgcn_readfirstlane(tid >> 6);
          norm_rows(WSP(const float, WS_X), P->g_ffn + l * DM, WSP(bf16_t, WS_HN), nullptr, blockIdx.x * 8 + wave, gridDim.x * 8, lane); }
        XSYNC();
        { KParams P = kparams(); unsigned char* ws = P->ws; unsigned char* wb = ws + WS_W + (size_t)l * LAYER_W;
          pg8::Gemm g{WSP(const bf16_t, WS_HN), (const bf16_t*)(wb + W_WGU), DM, DM, 0}; pg8::StaticOrder so; so.init(S, NGU, gridDim.x, blockIdx.x);
          EpiSwiGLU E{WSP(bf16_t, WS_ACT)}; pg8::gemm_phase<EpiSwiGLU, false>(lds, g, so, E); }
        XSYNC();
        { KParams P = kparams(); unsigned char* ws = P->ws; unsigned char* wb = ws + WS_W + (size_t)l * LAYER_W;
          pg8::Gemm g{WSP(const bf16_t, WS_ACT), (const bf16_t*)(wb + W_WDOWN), DFF, DFF, 0}; pg8::StaticOrder so; so.init(S, DM, gridDim.x, blockIdx.x);
          EpiResid E{WSP(const float, WS_X), WSP(float, WS_X)}; pg8::gemm_phase<EpiResid, false>(lds, g, so, E); }
        XSYNC();
    }
    { KParams P = kparams(); unsigned char* ws = P->ws; const int tid = otid(), lane = tid & 63, wave = __builtin_amdgcn_readfirstlane(tid >> 6);
      norm_rows(WSP(const float, WS_X), P->g_final, nullptr, P->out, blockIdx.x * 8 + wave, gridDim.x * 8, lane); }
}

extern "C" void kernel_launch(void* const* d_in, const int* in_sizes, int n_in, void* d_out, int out_size, void* d_ws, size_t ws_size, hipStream_t stream) {
    static int grid = 0;
    if (grid == 0) {
        if (n_in != 26 || ws_size < WS_END) { fprintf(stderr, "kernel_launch: unexpected n_in %d / ws_size %zu (need %zu)\n", n_in, ws_size, (size_t)WS_END); grid = -1; return; }
        int dev = 0, cus = 0, per_cu = 0;
        hipGetDevice(&dev); hipDeviceGetAttribute(&cus, hipDeviceAttributeMultiprocessorCount, dev);
        hipFuncSetAttribute((const void*)mega_fwd, hipFuncAttributeMaxDynamicSharedMemorySize, LDS_BYTES);
        hipOccupancyMaxActiveBlocksPerMultiprocessor(&per_cu, (const void*)mega_fwd, 512, LDS_BYTES);
        if (per_cu < 1) per_cu = 1;
        grid = cus * per_cu;
        (void)hipGetLastError();
    }
    if (grid < 0) return;
    if (hipMemsetAsync((char*)d_ws + WS_BAR, 0, (XCD_BAR_WORDS + 64 * DEPTH) * 4, stream) != hipSuccess) { fprintf(stderr, "memset failed\n"); return; }
    static short order_tab[N_ATT_UNITS];
    static bool sched_ok = false;
    if (!sched_ok) {
        int cost[N_ATT_UNITS], order[N_ATT_UNITS];
        for (int u = 0; u < N_ATT_UNITS; ++u) {
            int qb, wgt;
            if (u < 64) { qb = u >> 2; wgt = 48; } else if (u < 160) { qb = (u - 64) / 6; wgt = 40; } else if (u < 416) { qb = 16 + ((u - 160) >> 4); wgt = 12; } else { qb = 16 + ((u - 416) >> 1) / 6; wgt = 20; }
            cost[u] = wgt * (4 * qb + 4); order[u] = u;
        }
        for (int i = 1; i < N_ATT_UNITS; ++i) { const int u = order[i]; int j = i - 1; while (j >= 0 && (cost[order[j]] < cost[u])) { order[j + 1] = order[j]; --j; } order[j + 1] = u; }
        for (int i = 0; i < N_ATT_UNITS; ++i) order_tab[i] = (short)order[i];
        sched_ok = true;
    }
    Params p{};
    for (int i = 0; i < N_ATT_UNITS; ++i) p.order[i] = order_tab[i];
    p.x = (const float*)d_in[0]; p.pos = (const int*)d_in[1]; p.g_mix = (const float*)d_in[2]; p.w_in = (const float*)d_in[3]; p.conv_w = (const float*)d_in[4]; p.conv_b = (const float*)d_in[5];
    p.w_r = (const float*)d_in[6]; p.b_r = (const float*)d_in[7]; p.w_i = (const float*)d_in[8]; p.b_i = (const float*)d_in[9]; p.lru_lambda = (const float*)d_in[10];
    p.lam_q1 = (const float*)d_in[11]; p.lam_k1 = (const float*)d_in[12]; p.lam_q2 = (const float*)d_in[13]; p.lam_k2 = (const float*)d_in[14]; p.g_sub = (const float*)d_in[15];
    p.g_q_a = (const float*)d_in[16]; p.w_q_b = (const float*)d_in[17]; p.g_kv_a = (const float*)d_in[18]; p.w_kv_b = (const float*)d_in[19]; p.w_out = (const float*)d_in[20];
    p.g_ffn = (const float*)d_in[21]; p.w_gate = (const float*)d_in[22]; p.w_up = (const float*)d_in[23]; p.w_down = (const float*)d_in[24]; p.g_final = (const float*)d_in[25];
    p.out = (float*)d_out; p.ws = (unsigned char*)d_ws;
    void* args[] = {&p};
    hipError_t e = hipLaunchCooperativeKernel((const void*)mega_fwd, dim3(grid), dim3(512), args, LDS_BYTES, stream);
    if (e != hipSuccess) fprintf(stderr, "cooperative launch failed: %s (grid %d)\n", hipGetErrorString(e), grid);
}
```

```cpp
#include <hip/hip_runtime.h>
#include <hip/hip_cooperative_groups.h>
#include <cstdio>
#include <cstdint>
namespace cg = cooperative_groups;

#define LAS __attribute__((address_space(3)))
typedef unsigned short bf16_t;
typedef short bf16x8 __attribute__((ext_vector_type(8)));
typedef short s16x4 __attribute__((ext_vector_type(4)));
typedef float f32x4 __attribute__((ext_vector_type(4)));
typedef float f32x2 __attribute__((ext_vector_type(2)));
typedef float f32x16 __attribute__((ext_vector_type(16)));
typedef unsigned u32x4 __attribute__((ext_vector_type(4)));
typedef unsigned u32x2 __attribute__((ext_vector_type(2)));

constexpr int S = 8192, DM = 2048, DEPTH = 4;
constexpr int NPROJ = 4096;
constexpr int DFF = 5632;
constexpr int NQ = 1280;
constexpr int NKV = 1536;
constexpr int NKVP = 1600;
constexpr int NGU = 2 * DFF;
constexpr float NORM_EPS = 1e-6f, SUBLN_EPS = 1e-5f;

constexpr size_t MiB = 1u << 20;
constexpr size_t WS_SSQ = 0;
constexpr size_t WS_GB = 1 * MiB;
constexpr size_t WS_TABD = 2 * MiB;
constexpr size_t WS_TABM = 3 * MiB;
constexpr size_t WS_CP = 5 * MiB, WS_CH = 6 * MiB;
constexpr size_t WS_BAR = 7 * MiB + 512 * 1024;
constexpr size_t WS_ORDER = 7 * MiB;
constexpr size_t WS_W = 8 * MiB;
constexpr size_t W_WIN = 0, W_WQB = 16 * MiB, W_WKVB = 18 * MiB, W_WG = 19 * MiB, W_WOUT = 21 * MiB, W_WGU = 29 * MiB, W_WDOWN = 73 * MiB, LAYER_W = 95 * MiB;
constexpr size_t WS_X = WS_W + 4 * LAYER_W;
constexpr size_t WS_HN = WS_X + 64 * MiB;
constexpr size_t WS_MIX = WS_HN + 32 * MiB;
constexpr size_t WS_PROJ0 = WS_MIX + 32 * MiB;
constexpr size_t PROJ_PAD = 4 * NPROJ * 2;
constexpr size_t WS_ACT = WS_PROJ0 + 1 * MiB;
constexpr size_t WS_Q = WS_PROJ0 + 65 * MiB;
constexpr size_t WS_KV = WS_Q + 20 * MiB;
constexpr size_t WS_A = WS_KV + 26 * MiB;
constexpr size_t WS_B = WS_A + 24 * MiB;
constexpr size_t WS_STASH = WS_B + 24 * MiB;
constexpr size_t WS_PARTO = WS_STASH + 16 * MiB;
constexpr size_t WS_PARTML = WS_PARTO + 56 * MiB;
constexpr size_t WS_END = WS_PARTML + 1 * MiB;
static_assert(WS_ACT + (size_t)S * DFF * 2 <= WS_A, "ACT overlay");

constexpr int LDS_BYTES = 147456;

__device__ __forceinline__ unsigned f2bf(float f) { unsigned u = __builtin_bit_cast(unsigned, f); return (u + 0x7fffu + ((u >> 16) & 1u)) >> 16; }
__device__ __forceinline__ unsigned pk2(float lo, float hi) { return f2bf(lo) | (f2bf(hi) << 16); }
__device__ __forceinline__ float bf2f(unsigned v) { return __builtin_bit_cast(float, v << 16); }
typedef float f32x2_t_ __attribute__((ext_vector_type(2))); typedef __bf16 bf16x2_t_ __attribute__((ext_vector_type(2)));
__device__ __forceinline__ unsigned cvt_pk_bf16(float lo, float hi) { const f32x2_t_ v = {lo, hi}; const bf16x2_t_ b = __builtin_convertvector(v, bf16x2_t_); return __builtin_bit_cast(unsigned, b); }
__device__ __forceinline__ float wave_sum(float v) {
#pragma unroll
    for (int o = 1; o < 64; o <<= 1) v += __shfl_xor(v, o);
    return v;
}
__device__ __forceinline__ float fexp(float x) { return __builtin_amdgcn_exp2f(x * 1.4426950408889634f); }
__device__ __forceinline__ float sigmoidf_(float x) { return __builtin_amdgcn_rcpf(1.f + fexp(-x)); }
__device__ __forceinline__ float gelu_tanh(float y) { const float z = 0.7978845608028654f * (y + 0.044715f * y * y * y); const float t = 1.f - 2.f * __builtin_amdgcn_rcpf(fexp(2.f * z) + 1.f); return 0.5f * y * (1.f + t); }
__device__ __forceinline__ void rope4(f32x4& v0, f32x4& v1, const float* cs) {
    const f32x4 t0 = *(const f32x4*)cs, t1 = *(const f32x4*)(cs + 4);
    f32x4 a, b;
    a[0] = v0[0] * t0[0] - v0[1] * t0[1]; a[1] = v0[1] * t0[0] + v0[0] * t0[1];
    a[2] = v0[2] * t0[2] - v0[3] * t0[3]; a[3] = v0[3] * t0[2] + v0[2] * t0[3];
    b[0] = v1[0] * t1[0] - v1[1] * t1[1]; b[1] = v1[1] * t1[0] + v1[0] * t1[1];
    b[2] = v1[2] * t1[2] - v1[3] * t1[3]; b[3] = v1[3] * t1[2] + v1[2] * t1[3];
    v0 = a; v1 = b;
}

namespace pg8 {
constexpr int BM = 256, BK = 64, HALF = 128, HTB = HALF * BK * 2, STAGE_BYTES = 8 * HTB, NXCD = 8, WGM = 8;
__host__ __device__ __forceinline__ int lds_byte(int r, int c) { const int st = (r >> 4) * 2 + (c >> 5), rr = r & 15, cc = c & 31, ob = rr * 64 + cc * 2; return st * 1024 + (ob ^ (((ob >> 9) & 1) << 5)); }
__host__ __device__ __forceinline__ void stage_rc(int b, int& R, int& C) { const int st = b / 1024, sb = b % 1024, swz = sb ^ (((sb >> 9) & 1) << 5); R = (st >> 1) * 16 + swz / 64; C = (st & 1) * 32 + (swz % 64) / 2; }
__host__ __device__ __forceinline__ int perm32(int rho) { const int n = rho >> 4, i = rho & 15; return 8 * (i >> 2) + 4 * n + (i & 3); }

struct Unit { int pm, pn; };
struct Gemm { const bf16_t* A; const bf16_t* Bt; int lda, K; int a_pn_bytes; };

struct StaticOrder {
    int nM, nN, nwg, G, c;
    __device__ void init(int M, int N, int G_, int c_) { nM = M / BM; nN = N / BM; nwg = nM * nN; G = G_; c = c_; }
    __device__ bool next(int i, Unit& u) const {
        const long L = (long)i * G + c; if (L >= nwg) return false;
        int wgid = (int)L; { const int q = nwg / NXCD, r = nwg % NXCD, xcd = wgid % NXCD, off = wgid / NXCD; wgid = (xcd < r ? xcd * (q + 1) : r * (q + 1) + (xcd - r) * q) + off; }
        const int nig = WGM * nN, gid = wgid / nig, fm = gid * WGM, gsz = (nM - fm) < WGM ? (nM - fm) : WGM;
        u.pm = fm + ((wgid % nig) % gsz); u.pn = (wgid % nig) / gsz; return true;
    }
};

template <class Epi, bool CONV>
__device__ __forceinline__ void gemm_phase(LAS unsigned char* lds, const Gemm g, const StaticOrder& S_, const Epi& E) {
    int tid_ = threadIdx.x; asm volatile("" : "+v"(tid_));
    const int tid = tid_, wid = __builtin_amdgcn_readfirstlane(tid >> 6), lane = tid & 63, wr = wid >> 2, wc = wid & 3, fr = lane & 15, fq = lane >> 4;
    const int K = g.K, nt = K / BK, lda = g.lda;
    unsigned voffA[2], voffB[2];
#pragma unroll
    for (int i = 0; i < 2; ++i) { int R, C; stage_rc(tid * 16 + i * 8192, R, C); const int Rb = Epi::PERM ? ((R & ~31) + perm32(R & 31)) : R;
        voffA[i] = (unsigned)(R * lda + C) * 2u; voffB[i] = (unsigned)(Rb * K + C) * 2u; }
    const size_t kstep = (size_t)(BK * 2);
    const size_t hstepA = (size_t)HALF * lda * 2, hstepB = (size_t)HALF * K * 2;
    const size_t tstepA = 2 * hstepA, tstepB = 2 * hstepB;
    const unsigned ldsw = (unsigned)wid * 1024u;
    const int aoff = lds_byte(wr * 64 + fr, fq * 8), boff = lds_byte(wc * 32 + fr, fq * 8);
    auto akoff = [&](int t) -> long { if constexpr (CONV) return ((long)((t >> 1) - 3) * lda + (t & 1) * 64) * 2; else return (long)t * 128; };
#define PG8_SA(b, h) (((b) * 2 + (h)) * HTB)
#define PG8_SB(b, h) ((4 + (b) * 2 + (h)) * HTB)
#define PG8_STAGE(bufoff, gbase, voff) do { _Pragma("unroll") for (int _i = 0; _i < 2; ++_i) \
        __builtin_amdgcn_global_load_lds((const unsigned*)((const char*)(gbase) + (voff)[_i]), (LAS unsigned*)(lds + (bufoff) + ldsw + _i * 8192), 16, 0, 0); } while (0)
#define PG8_LDA(dst, b, h) do { _Pragma("unroll") for (int m = 0; m < 4; ++m) _Pragma("unroll") for (int k = 0; k < 2; ++k) dst[m][k] = *(const LAS bf16x8*)(lds + PG8_SA(b, h) + aoff + m * 2048 + k * 1024); } while (0)
#define PG8_LDB(dst, b, h) do { _Pragma("unroll") for (int n = 0; n < 2; ++n) _Pragma("unroll") for (int k = 0; k < 2; ++k) dst[n][k] = *(const LAS bf16x8*)(lds + PG8_SB(b, h) + boff + n * 2048 + k * 1024); } while (0)
#define PG8_MMA(ai, bj, At, Bt) do { __builtin_amdgcn_s_setprio(1); _Pragma("unroll") for (int m = 0; m < 4; ++m) _Pragma("unroll") for (int n = 0; n < 2; ++n) _Pragma("unroll") for (int k = 0; k < 2; ++k) \
        acc[ai][bj][m][n] = __builtin_amdgcn_mfma_f32_16x16x32_bf16(Bt[n][k], At[m][k], acc[ai][bj][m][n], 0, 0, 0); __builtin_amdgcn_s_setprio(0); } while (0)
#define PG8_WAIT_V(n) asm volatile("s_waitcnt vmcnt(" #n ")" ::: "memory")
#define PG8_WAIT_L(n) asm volatile("s_waitcnt lgkmcnt(" #n ")" ::: "memory")
#define PG8_BAR __builtin_amdgcn_s_barrier()
#define PG8_SCHED __builtin_amdgcn_sched_barrier(0)
    Unit cur, nxt; int ui = 0;
    if (!S_.next(0, cur)) return;
    f32x4 acc[2][2][4][2];
#pragma unroll
    for (int a = 0; a < 2; ++a)
#pragma unroll
        for (int b = 0; b < 2; ++b)
#pragma unroll
            for (int m = 0; m < 4; ++m)
#pragma unroll
                for (int n = 0; n < 2; ++n) acc[a][b][m][n] = (f32x4){0.f, 0.f, 0.f, 0.f};
    bf16x8 At[4][2], B0[2][2], B1[2][2];
    const char* cA = (const char*)g.A + (size_t)cur.pm * tstepA + (size_t)cur.pn * g.a_pn_bytes; const char* cB = (const char*)g.Bt + (size_t)cur.pn * tstepB;
    {
        const char* a0 = cA + akoff(0); const char* a1p = cA + akoff(1);
        PG8_STAGE(PG8_SB(0, 0), cB, voffB); PG8_STAGE(PG8_SB(0, 1), cB + hstepB, voffB); PG8_STAGE(PG8_SA(0, 0), a0, voffA); PG8_STAGE(PG8_SA(0, 1), a0 + hstepA, voffA);
        if (wr == 1) PG8_BAR;
        PG8_WAIT_V(2); PG8_BAR;
        PG8_STAGE(PG8_SB(1, 0), cB + kstep, voffB); PG8_STAGE(PG8_SA(1, 0), a1p, voffA); PG8_STAGE(PG8_SB(1, 1), cB + hstepB + kstep, voffB);
        PG8_WAIT_V(6); PG8_BAR;
    }
    for (;;) {
        const bool has_next = S_.next(ui + 1, nxt);
        const char* nA = has_next ? (const char*)g.A + (size_t)nxt.pm * tstepA + (size_t)nxt.pn * g.a_pn_bytes : cA; const char* nB = has_next ? (const char*)g.Bt + (size_t)nxt.pn * tstepB : cB;
        for (int t = 0; t < nt; t += 2) {
            const bool last = (t == nt - 2);
            const char* a1 = cA + akoff(t + 1);
            const char* a2 = last ? nA + akoff(0) : cA + akoff(t + 2); const char* b2 = last ? nB : cB + (size_t)(t + 2) * kstep;
            const char* a3 = last ? nA + akoff(1) : cA + akoff(t + 3); const char* b3 = b2 + kstep;
            PG8_LDB(B0, 0, 0); PG8_LDB(B1, 0, 1); PG8_SCHED; PG8_LDA(At, 0, 0); PG8_STAGE(PG8_SA(1, 1), a1 + hstepA, voffA);
            PG8_WAIT_V(8); PG8_WAIT_L(0); PG8_BAR; PG8_MMA(0, 0, At, B0); PG8_MMA(0, 1, At, B1); PG8_BAR; PG8_SCHED;
            PG8_LDA(At, 0, 1); PG8_STAGE(PG8_SB(0, 0), b2, voffB); PG8_STAGE(PG8_SB(0, 1), b2 + hstepB, voffB); PG8_STAGE(PG8_SA(0, 0), a2, voffA);
            PG8_WAIT_V(8); PG8_WAIT_L(0); PG8_BAR; PG8_MMA(1, 0, At, B0); PG8_MMA(1, 1, At, B1); PG8_BAR; PG8_SCHED;
            PG8_LDB(B0, 1, 0); PG8_LDB(B1, 1, 1); PG8_SCHED; PG8_LDA(At, 1, 0); PG8_STAGE(PG8_SA(0, 1), a2 + hstepA, voffA);
            PG8_WAIT_V(8); PG8_WAIT_L(0); PG8_BAR; PG8_MMA(0, 0, At, B0); PG8_MMA(0, 1, At, B1); PG8_BAR; PG8_SCHED;
            PG8_LDA(At, 1, 1); PG8_STAGE(PG8_SB(1, 0), b3, voffB); PG8_STAGE(PG8_SB(1, 1), b3 + hstepB, voffB); PG8_STAGE(PG8_SA(1, 0), a3, voffA);
            PG8_WAIT_V(8); PG8_WAIT_L(0); PG8_BAR; PG8_MMA(1, 0, At, B0); PG8_MMA(1, 1, At, B1); PG8_BAR; PG8_SCHED;
        }
        if (wr == 0) PG8_BAR;
        E(acc, cur, wr, wc, fr, fq);
        if (!has_next) break;
#pragma unroll
        for (int a = 0; a < 2; ++a)
#pragma unroll
            for (int b = 0; b < 2; ++b)
#pragma unroll
                for (int m = 0; m < 4; ++m)
#pragma unroll
                    for (int n = 0; n < 2; ++n) acc[a][b][m][n] = (f32x4){0.f, 0.f, 0.f, 0.f};
        cur = nxt; cA = nA; cB = nB; ++ui;
        if (wr == 1) PG8_BAR;
    }
    PG8_WAIT_V(0);
    PG8_BAR;
#undef PG8_SA
#undef PG8_SB
#undef PG8_STAGE
#undef PG8_LDA
#undef PG8_LDB
#undef PG8_MMA
#undef PG8_WAIT_V
#undef PG8_WAIT_L
#undef PG8_BAR
#undef PG8_SCHED
}
}

typedef const f32x4 (&AccT)[2][2][4][2];

struct EpiProj {
    static constexpr bool PERM = true;
    bf16_t* O; const float* tabd; const float* tabm; float* ssqp; bf16_t* KV;
    __device__ __forceinline__ void operator()(AccT acc, const pg8::Unit& u, int wr, int wc, int fr, int fq) const {
        const int row0 = u.pm * 256 + wr * 64 + fr, col0 = u.pn * 256 + wc * 32 + 8 * fq, pn = u.pn;
        const bool ropeD = (pn >= 6 && pn < 10) && ((wc & 1) == 0) && (fq < 2);
        const bool ropeM = (pn == 15) && (wc < 2);
        const int slot = (pn == 12 || pn == 13) ? (pn - 12) * 4 + wc : (pn == 14 ? 8 + wc : -1);
#pragma unroll
        for (int ai = 0; ai < 2; ++ai)
#pragma unroll
            for (int m = 0; m < 4; ++m) {
                const int row = row0 + ai * 128 + m * 16; bf16_t* rowp = O + (size_t)row * NPROJ + col0; float ss = 0.f;
#pragma unroll
                for (int bj = 0; bj < 2; ++bj) {
                    f32x4 v0 = acc[ai][bj][m][0], v1 = acc[ai][bj][m][1];
                    if (ropeD) rope4(v0, v1, tabd + (size_t)row * 16 + 8 * fq);
                    if (ropeM && bj == 0) rope4(v0, v1, tabm + (size_t)row * 64 + (16 * wc + 4 * fq) * 2);
                    ss += (v0[0] * v0[0] + v0[1] * v0[1]) + (v0[2] * v0[2] + v0[3] * v0[3]) + (v1[0] * v1[0] + v1[1] * v1[1]) + (v1[2] * v1[2] + v1[3] * v1[3]);
                    u32x4 w; w.x = cvt_pk_bf16(v0[0], v0[1]); w.y = cvt_pk_bf16(v0[2], v0[3]); w.z = cvt_pk_bf16(v1[0], v1[1]); w.w = cvt_pk_bf16(v1[2], v1[3]);
                    *(u32x4*)(rowp + bj * 128) = w;
                    if (ropeM && bj == 0) *(u32x4*)(KV + (size_t)row * NKVP + 1536 + wc * 32 + 8 * fq) = w;
                }
                if (slot >= 0) { ss += __shfl_xor(ss, 16); ss += __shfl_xor(ss, 32); if (fq == 0) ssqp[(size_t)row * 16 + slot] = ss; }
            }
    }
};
struct EpiScaleRope {
    static constexpr bool PERM = true;
    bf16_t* O; int ldc; const float* ssqp; int nparts4; float inv_n; const float* tabm; int rope_tile0;
    __device__ __forceinline__ void operator()(AccT acc, const pg8::Unit& u, int wr, int wc, int fr, int fq) const {
        const int row0 = u.pm * 256 + wr * 64 + fr, col0 = u.pn * 256 + wc * 32 + 8 * fq;
        const bool rp = u.pn >= rope_tile0;
#pragma unroll
        for (int ai = 0; ai < 2; ++ai)
#pragma unroll
            for (int m = 0; m < 4; ++m) {
                const int row = row0 + ai * 128 + m * 16; bf16_t* rowp = O + (size_t)row * ldc + col0;
                float sq; { const f32x4 a = *(const f32x4*)(ssqp + (size_t)row * 16); sq = (a[0] + a[1]) + (a[2] + a[3]); if (nparts4 > 1) { const f32x4 b = *(const f32x4*)(ssqp + (size_t)row * 16 + 4); sq += (b[0] + b[1]) + (b[2] + b[3]); } }
                const float rs = 1.f / sqrtf(sq * inv_n + NORM_EPS);
#pragma unroll
                for (int bj = 0; bj < 2; ++bj) {
                    f32x4 v0 = acc[ai][bj][m][0] * rs, v1 = acc[ai][bj][m][1] * rs;
                    if (rp) rope4(v0, v1, tabm + (size_t)row * 64 + (16 * (wc & 1) + 4 * fq) * 2);
                    u32x4 w; w.x = cvt_pk_bf16(v0[0], v0[1]); w.y = cvt_pk_bf16(v0[2], v0[3]); w.z = cvt_pk_bf16(v1[0], v1[1]); w.w = cvt_pk_bf16(v1[2], v1[3]);
                    *(u32x4*)(rowp + bj * 128) = w;
                }
            }
    }
};
struct EpiGate {
    static constexpr bool PERM = true;
    const bf16_t* PROJ; const float* conv_w; const float* conv_b; const float* gbr; const float* gbi; const float* spl; float* Aout; float* Bout;
    __device__ __forceinline__ void operator()(AccT acc, const pg8::Unit& u, int wr, int wc, int fr, int fq) const {
        const int row0 = u.pm * 256 + wr * 64 + fr;
#pragma unroll
        for (int n = 0; n < 2; ++n) {
            const int cb = u.pn * 128 + wc * 32 + 8 * fq + 4 * n;
            const f32x4 cw0 = *(const f32x4*)(conv_w + cb), cw1 = *(const f32x4*)(conv_w + 768 + cb), cw2 = *(const f32x4*)(conv_w + 1536 + cb), cw3 = *(const f32x4*)(conv_w + 2304 + cb);
            const f32x4 cbias = *(const f32x4*)(conv_b + cb), br = *(const f32x4*)(gbr + cb), bi = *(const f32x4*)(gbi + cb), sp = *(const f32x4*)(spl + cb);
#pragma unroll
            for (int ai = 0; ai < 2; ++ai)
#pragma unroll
                for (int m = 0; m < 4; ++m) {
                    const int row = row0 + ai * 128 + m * 16;
                    const bf16_t* xp = PROJ + (ptrdiff_t)(row - 3) * NPROJ + cb;
                    const u32x2 x0 = *(const u32x2*)xp, x1 = *(const u32x2*)(xp + NPROJ), x2 = *(const u32x2*)(xp + 2 * NPROJ), x3 = *(const u32x2*)(xp + 3 * NPROJ);
                    const f32x4 rr = acc[ai][0][m][n] + br, ii = acc[ai][1][m][n] + bi;
                    f32x4 av, bv;
#pragma unroll
                    for (int j = 0; j < 4; ++j) {
                        const unsigned w0 = (j < 2 ? x0.x : x0.y), w1 = (j < 2 ? x1.x : x1.y), w2 = (j < 2 ? x2.x : x2.y), w3 = (j < 2 ? x3.x : x3.y);
                        const int sh = (j & 1) ? 16 : 0;
                        const float f0 = bf2f((w0 >> sh) & 0xffffu), f1 = bf2f((w1 >> sh) & 0xffffu), f2 = bf2f((w2 >> sh) & 0xffffu), f3 = bf2f((w3 >> sh) & 0xffffu);
                        const float xc = cbias[j] + cw0[j] * f0 + cw1[j] * f1 + cw2[j] * f2 + cw3[j] * f3;
                        const float r = sigmoidf_(rr[j]), ig = sigmoidf_(ii[j]);
                        const float a = fexp(-sp[j] * r);
                        av[j] = a; bv[j] = sqrtf(fmaxf(1.f - a * a, 0.f)) * ig * xc;
                    }
                    *(f32x4*)(Aout + (size_t)row * 768 + cb) = av; *(f32x4*)(Bout + (size_t)row * 768 + cb) = bv;
                }
        }
    }
};
struct EpiResid {
    static constexpr bool PERM = false;
    const float* Xin; float* Xout;
    __device__ __forceinline__ void operator()(AccT acc, const pg8::Unit& u, int wr, int wc, int fr, int fq) const {
        const int row0 = u.pm * 256 + wr * 64 + fr, col0 = u.pn * 256 + wc * 32 + 4 * fq;
#pragma unroll
        for (int ai = 0; ai < 2; ++ai)
#pragma unroll
            for (int m = 0; m < 4; ++m) { const size_t off = (size_t)(row0 + ai * 128 + m * 16) * DM + col0;
#pragma unroll
                for (int bj = 0; bj < 2; ++bj)
#pragma unroll
                    for (int n = 0; n < 2; ++n) { const f32x4 b = *(const f32x4*)(Xin + off + bj * 128 + n * 16); *(f32x4*)(Xout + off + bj * 128 + n * 16) = b + acc[ai][bj][m][n]; } }
    }
};
struct EpiSwiGLU {
    static constexpr bool PERM = true;
    bf16_t* O;
    __device__ __forceinline__ void operator()(AccT acc, const pg8::Unit& u, int wr, int wc, int fr, int fq) const {
        const int row0 = u.pm * 256 + wr * 64 + fr, col0 = u.pn * 128 + wc * 32 + 8 * fq;
#pragma unroll
        for (int ai = 0; ai < 2; ++ai)
#pragma unroll
            for (int m = 0; m < 4; ++m) {
                bf16_t* rowp = O + (size_t)(row0 + ai * 128 + m * 16) * DFF + col0;
                f32x4 o0, o1;
#pragma unroll
                for (int j = 0; j < 4; ++j) { const float g0 = acc[ai][0][m][0][j], g1 = acc[ai][0][m][1][j];
                    o0[j] = g0 * sigmoidf_(g0) * acc[ai][1][m][0][j]; o1[j] = g1 * sigmoidf_(g1) * acc[ai][1][m][1][j]; }
                u32x4 w; w.x = cvt_pk_bf16(o0[0], o0[1]); w.y = cvt_pk_bf16(o0[2], o0[3]); w.z = cvt_pk_bf16(o1[0], o1[1]); w.w = cvt_pk_bf16(o1[2], o1[3]);
                *(u32x4*)rowp = w;
            }
    }
};

template <int D1, int D2>
__device__ __forceinline__ void attn_run(LAS unsigned char* lds, const bf16_t* Q1, int ldq1, const bf16_t* Q2, int ldq2, const bf16_t* K1, const bf16_t* K2, const bf16_t* V, int ldkv,
                                         int q0, int kt0, int kt1, float c, f32x16 (&O)[4], float& mrun, float& lsum) {
    constexpr int DQK = D1 + D2, NS = DQK / 16, KP = DQK * 2 + 16, VP = 320, KBY = 64 * KP, VBY = 64 * VP, SB = KBY + VBY, KCH = KP / 16, VCH = VP / 16, T = KCH + VCH, NDMAX = (T + 7) / 8;
    static_assert(KBY % 1024 == 0 && 3 * SB <= 139264, "attention LDS ring");
    int tid_ = threadIdx.x; asm volatile("" : "+v"(tid_));
    const int tid = tid_, lane = tid & 63, w = __builtin_amdgcn_readfirstlane(tid >> 6), r = lane & 31, h = lane >> 5;
    bf16x8 qf[NS];
    { const size_t qrow = (size_t)(q0 + 32 * w + r);
#pragma unroll
      for (int s = 0; s < NS; ++s) { if (16 * s < D1) qf[s] = *(const bf16x8*)(Q1 + qrow * ldq1 + 16 * s + 8 * h); else qf[s] = *(const bf16x8*)(Q2 + qrow * ldq2 + (16 * s - D1) + 8 * h); } }
    const int nd = (T - w + 7) / 8;
    const char* dp[NDMAX];
#pragma unroll
    for (int i = 0; i < NDMAX; ++i) {
        const int j = w + 8 * i; const bf16_t* src;
        if (j < KCH) { const int q = 64 * j + lane, row = q / KCH, cc = q % KCH; const int ce = (cc == KCH - 1) ? 0 : cc * 8;
            src = (ce < D1) ? K1 + (size_t)(64 * kt0 + row) * ldkv + ce : K2 + (size_t)(64 * kt0 + row) * ldkv + (ce - D1); }
        else { const int q = 64 * (j - KCH) + lane, row = q / VCH, cc = q % VCH; src = V + (size_t)(64 * kt0 + row) * ldkv + ((cc < 16) ? cc * 8 : 0); }
        dp[i] = (const char*)src;
    }
    const size_t tstep = (size_t)64 * ldkv * 2;
#define ATT_ISSUE(stage) do { _Pragma("unroll") for (int i_ = 0; i_ < NDMAX; ++i_) if (i_ < nd) { \
        __builtin_amdgcn_global_load_lds((const unsigned*)dp[i_], (LAS unsigned*)(lds + (stage) * SB + (w + 8 * i_) * 1024), 16, 0, 0); dp[i_] += tstep; } } while (0)
#define ATT_WAIT(keep_one) do { if (keep_one) { if (nd == NDMAX) asm volatile("s_waitcnt vmcnt(%0)" :: "n"(NDMAX) : "memory"); else asm volatile("s_waitcnt vmcnt(%0)" :: "n"(NDMAX - 1) : "memory"); } \
        else asm volatile("s_waitcnt vmcnt(0)" ::: "memory"); } while (0)
    const int n = kt1 - kt0;
    asm volatile("s_waitcnt vmcnt(0) lgkmcnt(0)" ::: "memory");
    __builtin_amdgcn_s_barrier();
    asm volatile("" ::: "memory");
    ATT_ISSUE(0);
    if (n > 1) ATT_ISSUE(1);
    ATT_WAIT(n > 1);
    __builtin_amdgcn_s_barrier();
    asm volatile("" ::: "memory");
    const int mylast = (q0 >> 6) + (w >> 1);
    float l = 0.f; mrun = -1e30f;
#pragma unroll
    for (int d = 0; d < 4; ++d)
#pragma unroll
        for (int i = 0; i < 16; ++i) O[d][i] = 0.f;
    const int g4 = lane >> 4, li = lane & 15;
    const int vb = KBY + (4 * h + (li >> 2)) * VP + (16 * (g4 & 1) + 4 * (li & 3)) * 2;
    const int kb0 = r * KP + 16 * h;
    const unsigned lds_base = (unsigned)(size_t)lds;
    int stg = 0;
    for (int it = 0; it < n; ++it) {
        const bool ahead = (it + 2 < n);
        if (ahead) { const int s2 = (stg >= 1) ? stg - 1 : 2; ATT_ISSUE(s2); }
        if (kt0 + it <= mylast) {
            const unsigned ka = lds_base + stg * SB + kb0, va = lds_base + stg * SB + vb;
            f32x16 st[2];
#pragma unroll
            for (int kb = 0; kb < 2; ++kb)
#pragma unroll
                for (int i = 0; i < 16; ++i) st[kb][i] = 0.f;
            {
                constexpr int NB = (2 * NS) / 4;
                bf16x8 fa[2][4];
#define K_OFF(idx) (32 * ((idx) / NS) * KP + 32 * ((idx) % NS))
#pragma unroll
                for (int i = 0; i < 4; ++i) asm volatile("ds_read_b128 %0, %1 offset:%2" : "=&v"(fa[0][i]) : "v"(ka), "i"(K_OFF(i)) : "memory");
#pragma unroll
                for (int b = 0; b < NB; ++b) {
                    if (b + 1 < NB) {
#pragma unroll
                        for (int i = 0; i < 4; ++i) asm volatile("ds_read_b128 %0, %1 offset:%2" : "=&v"(fa[(b + 1) & 1][i]) : "v"(ka), "i"(K_OFF(4 * (b + 1) + i)) : "memory");
                        asm volatile("s_waitcnt lgkmcnt(4)" : "+v"(fa[b & 1][0]), "+v"(fa[b & 1][1]), "+v"(fa[b & 1][2]), "+v"(fa[b & 1][3]) :: "memory");
                    } else asm volatile("s_waitcnt lgkmcnt(0)" : "+v"(fa[b & 1][0]), "+v"(fa[b & 1][1]), "+v"(fa[b & 1][2]), "+v"(fa[b & 1][3]) :: "memory");
#pragma unroll
                    for (int i = 0; i < 4; ++i) { constexpr int dummy = 0; (void)dummy; const int idx = 4 * b + i; st[idx / NS] = __builtin_amdgcn_mfma_f32_32x32x16_bf16(fa[b & 1][i], qf[idx % NS], st[idx / NS], 0, 0, 0); }
                }
#undef K_OFF
            }
            float mx = fmaxf(fmaxf(st[0][0], st[0][1]), fmaxf(st[1][0], st[1][1]));
#pragma unroll
            for (int i = 2; i < 16; i += 2) mx = fmaxf(mx, fmaxf(fmaxf(st[0][i], st[0][i + 1]), fmaxf(st[1][i], st[1][i + 1])));
            { const auto rr = __builtin_amdgcn_permlane32_swap(__float_as_uint(mx), __float_as_uint(mx), false, false); mx = fmaxf(__uint_as_float(rr[0]), __uint_as_float(rr[1])); }
            const float mnew = fmaxf(mrun, mx), alpha = __builtin_amdgcn_exp2f((mrun - mnew) * c), mc = mnew * c; mrun = mnew;
            float ps = 0.f;
#pragma unroll
            for (int kb = 0; kb < 2; ++kb)
#pragma unroll
                for (int i = 0; i < 16; ++i) { const float p = __builtin_amdgcn_exp2f(st[kb][i] * c - mc); st[kb][i] = p; ps += p; }
            l = l * alpha + ps;
#pragma unroll
            for (int d = 0; d < 4; ++d) O[d] = O[d] * alpha;
            bf16x8 pf[2][2];
#pragma unroll
            for (int kb = 0; kb < 2; ++kb)
#pragma unroll
                for (int sp = 0; sp < 2; ++sp) { u32x4 t; t.x = cvt_pk_bf16(st[kb][8 * sp + 0], st[kb][8 * sp + 1]); t.y = cvt_pk_bf16(st[kb][8 * sp + 2], st[kb][8 * sp + 3]);
                    t.z = cvt_pk_bf16(st[kb][8 * sp + 4], st[kb][8 * sp + 5]); t.w = cvt_pk_bf16(st[kb][8 * sp + 6], st[kb][8 * sp + 7]); pf[kb][sp] = __builtin_bit_cast(bf16x8, t); }
            {
                s16x4 vl[2][4], vh[2][4];
#define V_OFF(d, f) ((32 * ((f) >> 1) + 16 * ((f) & 1)) * VP + 64 * (d))
#pragma unroll
                for (int f = 0; f < 4; ++f) { asm volatile("ds_read_b64_tr_b16 %0, %1 offset:%2" : "=&v"(vl[0][f]) : "v"(va), "i"(V_OFF(0, f)) : "memory");
                                              asm volatile("ds_read_b64_tr_b16 %0, %1 offset:%2" : "=&v"(vh[0][f]) : "v"(va), "i"(V_OFF(0, f) + 8 * VP) : "memory"); }
#pragma unroll
                for (int d = 0; d < 4; ++d) {
                    if (d + 1 < 4) {
#pragma unroll
                        for (int f = 0; f < 4; ++f) { asm volatile("ds_read_b64_tr_b16 %0, %1 offset:%2" : "=&v"(vl[(d + 1) & 1][f]) : "v"(va), "i"(V_OFF(d + 1, f)) : "memory");
                                                      asm volatile("ds_read_b64_tr_b16 %0, %1 offset:%2" : "=&v"(vh[(d + 1) & 1][f]) : "v"(va), "i"(V_OFF(d + 1, f) + 8 * VP) : "memory"); }
                        asm volatile("s_waitcnt lgkmcnt(8)" : "+v"(vl[d & 1][0]), "+v"(vl[d & 1][1]), "+v"(vl[d & 1][2]), "+v"(vl[d & 1][3]), "+v"(vh[d & 1][0]), "+v"(vh[d & 1][1]), "+v"(vh[d & 1][2]), "+v"(vh[d & 1][3]) :: "memory");
                    } else asm volatile("s_waitcnt lgkmcnt(0)" : "+v"(vl[d & 1][0]), "+v"(vl[d & 1][1]), "+v"(vl[d & 1][2]), "+v"(vl[d & 1][3]), "+v"(vh[d & 1][0]), "+v"(vh[d & 1][1]), "+v"(vh[d & 1][2]), "+v"(vh[d & 1][3]) :: "memory");
#pragma unroll
                    for (int f = 0; f < 4; ++f) { const s16x4 lo = vl[d & 1][f], hi = vh[d & 1][f];
                        const bf16x8 vf = (bf16x8){lo[0], lo[1], lo[2], lo[3], hi[0], hi[1], hi[2], hi[3]};
                        O[d] = __builtin_amdgcn_mfma_f32_32x32x16_bf16(vf, pf[f >> 1][f & 1], O[d], 0, 0, 0); }
                }
#undef V_OFF
            }
        }
        ATT_WAIT(ahead);
        __builtin_amdgcn_s_barrier();
        asm volatile("" ::: "memory");
        stg = (stg == 2) ? 0 : stg + 1;
    }
#undef ATT_ISSUE
#undef ATT_WAIT
    lsum = l + __shfl_xor(l, 32);
}

struct AttnArgs { const bf16_t* PROJ; const bf16_t* Qb; const bf16_t* KVb; bf16_t* MIX; float* stash; float* part_o; float* part_ml; const float* g_sub; float lam; float one_m_linit; };
constexpr float C_DIFF = 0.125f * 1.4426950408889634f, C_MLA = 0.07216878364870322f * 1.4426950408889634f;

__device__ __forceinline__ void attn_store_part(const AttnArgs& a, int pi, size_t qrow, int h, const f32x16 (&O)[4], float mrun, float lsum) {
    float* po = a.part_o + ((size_t)pi * 4096 + (qrow - 4096)) * 128;
#pragma unroll
    for (int d = 0; d < 4; ++d)
#pragma unroll
        for (int g = 0; g < 4; ++g) { f32x4 v = {O[d][4 * g], O[d][4 * g + 1], O[d][4 * g + 2], O[d][4 * g + 3]}; *(f32x4*)(po + 32 * d + 8 * g + 4 * h) = v; }
    if (h == 0) { f32x2 ml = {mrun, lsum}; *(f32x2*)(a.part_ml + ((size_t)pi * 4096 + (qrow - 4096)) * 2) = ml; }
}
__device__ __forceinline__ void attn_unit_diff_part(LAS unsigned char* lds, const AttnArgs& a, int hd, int map, int qb, int part) {
    int tid_ = threadIdx.x; asm volatile("" : "+v"(tid_));
    const int tid = tid_, lane = tid & 63, w = tid >> 6, r = lane & 31, h = lane >> 5;
    const int q0 = 256 * qb, nt = 4 * qb + 4, kt0 = part ? nt / 2 : 0, kt1 = part ? nt : nt / 2; const size_t qrow = (size_t)(q0 + 32 * w + r);
    f32x16 O[4]; float mrun, lsum;
    attn_run<64, 0>(lds, a.PROJ + 1536 + 128 * hd + 64 * map, NPROJ, nullptr, 0, a.PROJ + 2048 + 128 * hd + 64 * map, nullptr, a.PROJ + 2560 + 128 * hd, NPROJ, q0, kt0, kt1, C_DIFF, O, mrun, lsum);
    attn_store_part(a, (hd * 2 + map) * 2 + part, qrow, h, O, mrun, lsum);
}
__device__ __forceinline__ void attn_unit_mla_part(LAS unsigned char* lds, const AttnArgs& a, int hh, int qb, int part) {
    int tid_ = threadIdx.x; asm volatile("" : "+v"(tid_));
    const int tid = tid_, lane = tid & 63, w = tid >> 6, r = lane & 31, h = lane >> 5;
    const int q0 = 256 * qb, nt = 4 * qb + 4, kt0 = part ? nt / 2 : 0, kt1 = part ? nt : nt / 2; const size_t qrow = (size_t)(q0 + 32 * w + r);
    f32x16 O[4]; float mrun, lsum;
    attn_run<128, 64>(lds, a.Qb + 128 * hh, NQ, a.Qb + 768 + 64 * hh, NQ, a.KVb + 128 * hh, a.KVb + 1536, a.KVb + 768 + 128 * hh, NKVP, q0, kt0, kt1, C_MLA, O, mrun, lsum);
    attn_store_part(a, (8 + hh) * 2 + part, qrow, h, O, mrun, lsum);
}
__device__ __forceinline__ void attn_unit_diff(LAS unsigned char* lds, const AttnArgs& a, int hd, int qb) {
    int tid_ = threadIdx.x; asm volatile("" : "+v"(tid_));
    const int tid = tid_, lane = tid & 63, w = tid >> 6, r = lane & 31, h = lane >> 5;
    const int q0 = 256 * qb, nt = 4 * qb + 4; const size_t qrow = (size_t)(q0 + 32 * w + r);
    f32x16 O[4]; float mrun, lsum;
    float* st = a.stash + ((size_t)hd * S + qrow) * 128;
    const bf16_t* Vp = a.PROJ + 2560 + 128 * hd;
    attn_run<64, 0>(lds, a.PROJ + 1536 + 128 * hd, NPROJ, nullptr, 0, a.PROJ + 2048 + 128 * hd, nullptr, Vp, NPROJ, q0, 0, nt, C_DIFF, O, mrun, lsum);
    { const float linv = 1.f / lsum;
#pragma unroll
      for (int d = 0; d < 4; ++d)
#pragma unroll
        for (int g = 0; g < 4; ++g) { f32x4 v = {O[d][4 * g] * linv, O[d][4 * g + 1] * linv, O[d][4 * g + 2] * linv, O[d][4 * g + 3] * linv}; *(f32x4*)(st + 32 * d + 8 * g + 4 * h) = v; } }
    attn_run<64, 0>(lds, a.PROJ + 1536 + 128 * hd + 64, NPROJ, nullptr, 0, a.PROJ + 2048 + 128 * hd + 64, nullptr, Vp, NPROJ, q0, 0, nt, C_DIFF, O, mrun, lsum);
    float ss = 0.f; const float ll = a.lam / lsum;
#pragma unroll
    for (int d = 0; d < 4; ++d)
#pragma unroll
        for (int g = 0; g < 4; ++g) { const f32x4 s1 = *(const f32x4*)(st + 32 * d + 8 * g + 4 * h);
#pragma unroll
            for (int j = 0; j < 4; ++j) { const float o = s1[j] - ll * O[d][4 * g + j]; O[d][4 * g + j] = o; ss += o * o; } }
    ss += __shfl_xor(ss, 32);
    const float rs = a.one_m_linit / sqrtf(ss * (1.f / 128.f) + SUBLN_EPS);
    bf16_t* op = a.MIX + qrow * DM + 768 + 128 * hd;
#pragma unroll
    for (int d = 0; d < 4; ++d)
#pragma unroll
        for (int g = 0; g < 4; ++g) { const int dv = 32 * d + 8 * g + 4 * h; const f32x4 gs = *(const f32x4*)(a.g_sub + dv);
            u32x2 o; o.x = cvt_pk_bf16(O[d][4 * g] * rs * gs[0], O[d][4 * g + 1] * rs * gs[1]); o.y = cvt_pk_bf16(O[d][4 * g + 2] * rs * gs[2], O[d][4 * g + 3] * rs * gs[3]);
            *(u32x2*)(op + dv) = o; }
}
__device__ __forceinline__ void attn_unit_mla(LAS unsigned char* lds, const AttnArgs& a, int hh, int qb) {
    int tid_ = threadIdx.x; asm volatile("" : "+v"(tid_));
    const int tid = tid_, lane = tid & 63, w = tid >> 6, r = lane & 31, h = lane >> 5;
    const int q0 = 256 * qb, nt = 4 * qb + 4; const size_t qrow = (size_t)(q0 + 32 * w + r);
    f32x16 O[4]; float mrun, lsum;
    attn_run<128, 64>(lds, a.Qb + 128 * hh, NQ, a.Qb + 768 + 64 * hh, NQ, a.KVb + 128 * hh, a.KVb + 1536, a.KVb + 768 + 128 * hh, NKVP, q0, 0, nt, C_MLA, O, mrun, lsum);
    const float linv = 1.f / lsum;
    bf16_t* op = a.MIX + qrow * DM + 1280 + 128 * hh;
#pragma unroll
    for (int d = 0; d < 4; ++d)
#pragma unroll
        for (int g = 0; g < 4; ++g) { const int dv = 32 * d + 8 * g + 4 * h;
            u32x2 o; o.x = cvt_pk_bf16(O[d][4 * g] * linv, O[d][4 * g + 1] * linv); o.y = cvt_pk_bf16(O[d][4 * g + 2] * linv, O[d][4 * g + 3] * linv);
            *(u32x2*)(op + dv) = o; }
}
constexpr int N_ATT_UNITS = 608, SCHED_SLOTS = 5;
__device__ __forceinline__ void attn_dispatch(LAS unsigned char* lds, const AttnArgs& a, int u) {
    if (u < 64) attn_unit_diff(lds, a, u & 3, u >> 2);
    else if (u < 160) { const int v = u - 64; attn_unit_mla(lds, a, v % 6, v / 6); }
    else if (u < 416) { const int v = u - 160; attn_unit_diff_part(lds, a, (v >> 2) & 3, (v >> 1) & 1, 16 + (v >> 4), v & 1); }
    else { const int v = u - 416; attn_unit_mla_part(lds, a, (v >> 1) % 6, 16 + (v >> 1) / 6, v & 1); }
}

template <class F>
__device__ __forceinline__ void conv_mat(const F f, bf16_t* WT, int N, int K, LAS float* scr, int gw, int NGW, int lane) {
    const int nblk = N / 32, nitems = (K / 64) * nblk;
    for (int it = gw; it < nitems; it += NGW) {
        const int kb = it / nblk, nb = it % nblk, k0 = 64 * kb, n0 = 32 * nb;
        float v[32];
#pragma unroll
        for (int i = 0; i < 32; ++i) v[i] = f(k0 + 2 * i + (lane >> 5), n0 + (lane & 31));
#pragma unroll
        for (int i = 0; i < 32; ++i) scr[(2 * i + (lane >> 5)) * 33 + (lane & 31)] = v[i];
        asm volatile("s_waitcnt lgkmcnt(0)" ::: "memory");
        const int c = lane & 7;
#pragma unroll
        for (int j = 0; j < 4; ++j) { const int n = (lane >> 3) + 8 * j; const LAS float* s = scr + (8 * c) * 33 + n;
            u32x4 o; o.x = pk2(s[0 * 33], s[1 * 33]); o.y = pk2(s[2 * 33], s[3 * 33]); o.z = pk2(s[4 * 33], s[5 * 33]); o.w = pk2(s[6 * 33], s[7 * 33]);
            *(u32x4*)(WT + (size_t)(n0 + n) * K + k0 + 8 * c) = o; }
        asm volatile("s_waitcnt lgkmcnt(0)" ::: "memory");
    }
}
struct FPlain { const float* W; int N; __device__ __forceinline__ float operator()(int k, int n) const { return W[(size_t)k * N + n]; } };
struct FWin { const float* W; __device__ __forceinline__ float operator()(int k, int n) const {
    int src = n;
    if (n >= 1536 && n < 2560) { const int p = n & 63; if (p < 16) src = (n & ~63) + ((p & 1) ? 8 + (p >> 1) : (p >> 1)); }
    else if (n >= 3840) { const int p = n - 3840; if (p >= 64) return 0.f; src = 3840 + ((p & 1) ? 32 + (p >> 1) : (p >> 1)); }
    return W[(size_t)k * 3904 + src]; } };
struct FQb { const float* W; const float* g; __device__ __forceinline__ float operator()(int k, int n) const {
    if (n >= 1152) return 0.f; int src;
    if (n < 768) src = 192 * (n >> 7) + (n & 127); else { const int hh = (n - 768) >> 6, p = (n - 768) & 63; src = 192 * hh + 128 + ((p & 1) ? 32 + (p >> 1) : (p >> 1)); }
    return W[(size_t)k * 1152 + src] * g[k]; } };
struct FKVb { const float* W; const float* g; __device__ __forceinline__ float operator()(int k, int n) const {
    int src; if (n < 768) src = 256 * (n >> 7) + (n & 127); else src = 256 * ((n - 768) >> 7) + 128 + ((n - 768) & 127);
    return W[(size_t)k * 1536 + src] * g[k]; } };
struct FGate { const float* cw; const float* wr; const float* wi; __device__ __forceinline__ float operator()(int kk, int n) const {
    const int j = kk >> 7, k = kk & 127, hb = n >> 8, isI = (n >> 7) & 1, c = n & 127;
    const ptrdiff_t d = (const char*)wi - (const char*)wr; const float* wsel = (const float*)((const char*)wr + (isI ? d : (ptrdiff_t)0));
    return cw[j * 768 + 128 * hb + k] * wsel[((size_t)hb * 128 + k) * 128 + c]; } };
struct FGU { const float* wg; const float* wu; __device__ __forceinline__ float operator()(int k, int n) const {
    const int t = n >> 8, rr = n & 255, src = 128 * t + (rr & 127); const ptrdiff_t d = (const char*)wu - (const char*)wg; const float* wsel = (const float*)((const char*)wg + (rr < 128 ? (ptrdiff_t)0 : d));
    return wsel[(size_t)k * DFF + src]; } };


#define XB_TMO      128
#define XB_XCNT(j)  (256  + 64 * (j))
#define XB_XSUB(j)  (1280 + 64 * (j))
#define XB_XGEN(j)  (2304 + 64 * (j))
#define XB_TOP      3328
#define XB_TOPGEN   3392
#define XCD_BAR_WORDS 3456
#define XB_SPIN_CAP (1u << 22)
__device__ __forceinline__ unsigned xb_ld(unsigned* p)              { return __hip_atomic_load(p, __ATOMIC_RELAXED, __HIP_MEMORY_SCOPE_AGENT); }
__device__ __forceinline__ unsigned xb_add(unsigned* p, unsigned v) { return __hip_atomic_fetch_add(p, v, __ATOMIC_RELAXED, __HIP_MEMORY_SCOPE_AGENT); }
__device__ __forceinline__ unsigned xb_xcc_id() { return (unsigned)__builtin_amdgcn_s_getreg((3 << 11) | 20) & 0xFu; }
#define XB_SPIN(cond, bar) do { unsigned _sp = 0; while (cond) { __builtin_amdgcn_s_sleep(1); \
    if ((++_sp & 255u) == 0u) { if (xb_ld(&(bar)[XB_TMO])) break; if (_sp > XB_SPIN_CAP) { atomicAdd(&(bar)[XB_TMO], 1u); break; } } } } while (0)
struct XcdBarrier { unsigned* bar; unsigned x; volatile LAS unsigned* st; };
__device__ __forceinline__ XcdBarrier xcd_barrier_post(unsigned* bar, volatile LAS unsigned* st) {
    XcdBarrier b; b.bar = bar; b.x = xb_xcc_id(); b.st = st;
    if (threadIdx.x == 0) (void)xb_add(&bar[XB_XCNT(b.x)], 1u);
    return b;
}
__device__ __forceinline__ void xcd_barrier_complete(unsigned* bar, unsigned x, unsigned& nloc, unsigned& nx) {
    const unsigned G = gridDim.x * gridDim.y * gridDim.z;
    unsigned sum, cnt, mine, sp = 0u;
    for (;;) {
        sum = 0u; cnt = 0u; mine = 0u;
#pragma unroll
        for (unsigned j = 0; j < 16; ++j) { const unsigned c = xb_ld(&bar[XB_XCNT(j)]); sum += c; cnt += (c > 0u) ? 1u : 0u; mine = (j == x) ? c : mine; }
        if (sum == G) break;
        __builtin_amdgcn_s_sleep(1);
        if ((++sp & 255u) == 0u) { if (xb_ld(&bar[XB_TMO])) break; if (sp > XB_SPIN_CAP) { atomicAdd(&bar[XB_TMO], 1u); break; } }
    }
    nloc = mine > 0u ? mine : 1u; nx = cnt > 0u ? cnt : 1u;
}
__device__ __forceinline__ void xcd_barrier(unsigned* bar, volatile LAS unsigned* st) {
    asm volatile("s_waitcnt vmcnt(0)" ::: "memory");
    __syncthreads();
    if (threadIdx.x == 0) {
        const unsigned x = xb_xcc_id();
        __builtin_amdgcn_s_waitcnt(0);
        unsigned nloc = st[0], nx = st[1];
        if (nloc == 0u) { xcd_barrier_complete(bar, x, nloc, nx); st[0] = nloc; st[1] = nx; }
        const unsigned old = xb_add(&bar[XB_XSUB(x)], 1u);
        const unsigned gen = old / nloc;
        if (old + 1u == (gen + 1u) * nloc) {
            __builtin_amdgcn_fence(__ATOMIC_RELEASE, "agent");
            asm volatile("s_waitcnt vmcnt(0)" ::: "memory");
            const unsigned og = xb_add(&bar[XB_TOP], 1u);
            const unsigned tg = og / nx;
            if (og + 1u == (tg + 1u) * nx) xb_add(&bar[XB_TOPGEN], 1u);
            else XB_SPIN(xb_ld(&bar[XB_TOPGEN]) == tg, bar);
            __builtin_amdgcn_fence(__ATOMIC_ACQUIRE, "agent");
            xb_add(&bar[XB_XGEN(x)], 1u);
            asm volatile("s_waitcnt vmcnt(0)" ::: "memory");
        } else {
            XB_SPIN(xb_ld(&bar[XB_XGEN(x)]) == gen, bar);
            __builtin_amdgcn_fence(__ATOMIC_ACQUIRE, "agent");
            asm volatile("s_waitcnt vmcnt(0)" ::: "memory");
        }
    }
    __syncthreads();
}
struct Params {
    const float* x; const int* pos; const float *g_mix, *w_in, *conv_w, *conv_b, *w_r, *b_r, *w_i, *b_i, *lru_lambda, *lam_q1, *lam_k1, *lam_q2, *lam_k2, *g_sub, *g_q_a, *w_q_b, *g_kv_a, *w_kv_b,
        *w_out, *g_ffn, *w_gate, *w_up, *w_down, *g_final;
    float* out; unsigned char* ws;
    short order[N_ATT_UNITS];
};

__device__ __forceinline__ void norm_rows(const float* X, const float* g, bf16_t* ob, float* of, int gw, int NGW, int lane) {
    for (int row = gw; row < S; row += NGW) {
        const f32x4* xr = (const f32x4*)(X + (size_t)row * DM) + lane;
        f32x4 v[8]; float ss = 0.f;
#pragma unroll
        for (int j = 0; j < 8; ++j) { v[j] = xr[64 * j]; ss += (v[j][0] * v[j][0] + v[j][1] * v[j][1]) + (v[j][2] * v[j][2] + v[j][3] * v[j][3]); }
        const float rstd = 1.f / sqrtf(wave_sum(ss) * (1.f / DM) + NORM_EPS);
#pragma unroll
        for (int j = 0; j < 8; ++j) { const f32x4 gg = ((const f32x4*)g)[lane + 64 * j]; const f32x4 o = v[j] * rstd * gg;
            if (of) ((f32x4*)(of + (size_t)row * DM))[lane + 64 * j] = o;
            else { u32x2 w; w.x = pk2(o[0], o[1]); w.y = pk2(o[2], o[3]); ((u32x2*)(ob + (size_t)row * DM))[lane + 64 * j] = w; } }
    }
}

typedef const __attribute__((address_space(4))) Params* KParams;
__device__ __forceinline__ KParams kparams() { auto kp = __builtin_amdgcn_kernarg_segment_ptr(); asm volatile("" : "+s"(kp)); return (KParams)kp; }
__device__ __forceinline__ int otid() { int t = threadIdx.x; asm volatile("" : "+v"(t)); return t; }
#define WSP(T, off) ((T*)(ws + (off)))
#define GSYNC() do { asm volatile("s_waitcnt vmcnt(0) lgkmcnt(0)" ::: "memory"); grid.sync(); __builtin_amdgcn_fence(__ATOMIC_ACQUIRE, "agent"); asm volatile("s_waitcnt vmcnt(0)" ::: "memory"); } while (0)

__global__ void __launch_bounds__(512, 2) mega_fwd(Params p_unused) {
    extern __shared__ __attribute__((aligned(16))) unsigned char lds_raw[];
    LAS unsigned char* lds = (LAS unsigned char*)lds_raw;
    cg::grid_group grid = cg::this_grid();
    volatile LAS unsigned* bst = (volatile LAS unsigned*)(lds + LDS_BYTES - 64);
    if (threadIdx.x < 2) bst[threadIdx.x] = 0u;
    __syncthreads();
    { KParams P = kparams(); (void)xcd_barrier_post((unsigned*)(P->ws + WS_BAR), bst); }
#define XSYNC() do { KParams P_ = kparams(); xcd_barrier((unsigned*)(P_->ws + WS_BAR), bst); } while (0)

    {
        KParams P = kparams(); unsigned char* ws = P->ws;
        const int tid = otid(), lane = tid & 63, wave = __builtin_amdgcn_readfirstlane(tid >> 6);
        const int G = gridDim.x, bx = blockIdx.x, gw = bx * 8 + wave, NGW = G * 8, gt = bx * 512 + tid, NT = G * 512;
        float* GBR = WSP(float, WS_GB); float* GBI = GBR + DEPTH * 768; float* SPL = GBI + DEPTH * 768;
        float* TABD = WSP(float, WS_TABD); float* TABM = WSP(float, WS_TABM);
        for (int i = gt; i < (int)(PROJ_PAD / 4); i += NT) WSP(unsigned, WS_PROJ0)[i] = 0u;
        const int* pos = P->pos;
        for (int i = gt; i < S * 40; i += NT) {
            const int t = i / 40, e = i % 40; const bool dd = e < 8; const int fi = dd ? e : e - 8; const float half = dd ? 8.f : 32.f;
            const float inv = exp2f(-(float)fi / half * 18.931568569324174f);
            const float ang = (float)pos[t] * inv;
            const double rev = (double)ang * 0.15915494309189535; const float fr = (float)(rev - rint(rev));
            const float cs = __builtin_amdgcn_cosf(fr), sn = __builtin_amdgcn_sinf(fr);
            float* dst = dd ? TABD + ((size_t)t * 8 + fi) * 2 : TABM + ((size_t)t * 32 + fi) * 2; dst[0] = cs; dst[1] = sn;
        }
        {
            const float* b_r = P->b_r; const float* b_i = P->b_i; const float* w_r = P->w_r; const float* w_i = P->w_i; const float* conv_b = P->conv_b; const float* lam = P->lru_lambda;
            for (int o = gw; o < DEPTH * 768; o += NGW) {
                const int l = o / 768, cch = o % 768, hb = cch >> 7, cc = cch & 127;
                const float* wr_ = w_r + ((size_t)l * 6 + hb) * 128 * 128 + cc; const float* wi_ = w_i + ((size_t)l * 6 + hb) * 128 * 128 + cc; const float* cb = conv_b + l * 768 + hb * 128;
                float sr = 0.f, si = 0.f;
#pragma unroll
                for (int k = lane; k < 128; k += 64) { const float cv = cb[k]; sr += cv * wr_[k * 128]; si += cv * wi_[k * 128]; }
                sr = wave_sum(sr); si = wave_sum(si);
                if (lane == 0) { GBR[o] = sr + b_r[o]; GBI[o] = si + b_i[o]; SPL[o] = 8.f * log1pf(expf(-lam[o])); }
            }
        }
        norm_rows(P->x, P->g_mix, WSP(bf16_t, WS_HN), nullptr, gw, NGW, lane);
        LAS float* scr = (LAS float*)(lds + wave * 8448);
#pragma unroll 1
        for (int l = 0; l < DEPTH; ++l) {
            unsigned char* wb = ws + WS_W + (size_t)l * LAYER_W;
            conv_mat(FWin{P->w_in + (size_t)l * DM * 3904}, (bf16_t*)(wb + W_WIN), NPROJ, DM, scr, gw, NGW, lane);
            conv_mat(FQb{P->w_q_b + (size_t)l * 512 * 1152, P->g_q_a + l * 512}, (bf16_t*)(wb + W_WQB), NQ, 512, scr, (gw + 517) % NGW, NGW, lane);
            conv_mat(FKVb{P->w_kv_b + (size_t)l * 256 * 1536, P->g_kv_a + l * 256}, (bf16_t*)(wb + W_WKVB), NKV, 256, scr, (gw + 837) % NGW, NGW, lane);
            conv_mat(FGate{P->conv_w + (size_t)l * 4 * 768, P->w_r + (size_t)l * 6 * 128 * 128, P->w_i + (size_t)l * 6 * 128 * 128}, (bf16_t*)(wb + W_WG), 1536, 512, scr, (gw + 1029) % NGW, NGW, lane);
            conv_mat(FPlain{P->w_out + (size_t)l * DM * DM, DM}, (bf16_t*)(wb + W_WOUT), DM, DM, scr, (gw + 1413) % NGW, NGW, lane);
            conv_mat(FGU{P->w_gate + (size_t)l * DM * DFF, P->w_up + (size_t)l * DM * DFF}, (bf16_t*)(wb + W_WGU), NGU, DM, scr, gw, NGW, lane);
            conv_mat(FPlain{P->w_down + (size_t)l * DFF * DM, DM}, (bf16_t*)(wb + W_WDOWN), DM, DFF, scr, gw, NGW, lane);
        }
    }
    GSYNC();

#pragma unroll 1
    for (int l = 0; l < DEPTH; ++l) {
        if (l > 0) {
          { KParams P = kparams(); unsigned char* ws = P->ws; const int tid = otid(), lane = tid & 63, wave = __builtin_amdgcn_readfirstlane(tid >> 6);
            norm_rows(WSP(const float, WS_X), P->g_mix + l * DM, WSP(bf16_t, WS_HN), nullptr, blockIdx.x * 8 + wave, gridDim.x * 8, lane); }
          XSYNC();
        }
        { KParams P = kparams(); unsigned char* ws = P->ws; unsigned char* wb = ws + WS_W + (size_t)l * LAYER_W;
          pg8::Gemm g{WSP(const bf16_t, WS_HN), (const bf16_t*)(wb + W_WIN), DM, DM, 0}; pg8::StaticOrder so; so.init(S, NPROJ, gridDim.x, blockIdx.x);
          EpiProj E{WSP(bf16_t, WS_PROJ0 + PROJ_PAD), WSP(const float, WS_TABD), WSP(const float, WS_TABM), WSP(float, WS_SSQ), WSP(bf16_t, WS_KV)}; pg8::gemm_phase<EpiProj, false>(lds, g, so, E); }
        XSYNC();
        { KParams P = kparams(); unsigned char* ws = P->ws; unsigned char* wb = ws + WS_W + (size_t)l * LAYER_W;
          pg8::Gemm g{WSP(const bf16_t, WS_PROJ0 + PROJ_PAD) + 3072, (const bf16_t*)(wb + W_WQB), NPROJ, 512, 0}; pg8::StaticOrder so; so.init(S, NQ, gridDim.x, blockIdx.x);
          EpiScaleRope E{WSP(bf16_t, WS_Q), NQ, WSP(const float, WS_SSQ), 2, 1.f / 512.f, WSP(const float, WS_TABM), 3}; pg8::gemm_phase<EpiScaleRope, false>(lds, g, so, E); }
        { KParams P = kparams(); unsigned char* ws = P->ws; unsigned char* wb = ws + WS_W + (size_t)l * LAYER_W;
          pg8::Gemm g{WSP(const bf16_t, WS_PROJ0 + PROJ_PAD) + 3584, (const bf16_t*)(wb + W_WKVB), NPROJ, 256, 0}; pg8::StaticOrder so; so.init(S, NKV, gridDim.x, (blockIdx.x + 96) % gridDim.x);
          EpiScaleRope E{WSP(bf16_t, WS_KV), NKVP, WSP(const float, WS_SSQ) + 8, 1, 1.f / 256.f, WSP(const float, WS_TABM), 1000}; pg8::gemm_phase<EpiScaleRope, false>(lds, g, so, E); }
        { KParams P = kparams(); unsigned char* ws = P->ws; unsigned char* wb = ws + WS_W + (size_t)l * LAYER_W; const bf16_t* PROJ = WSP(const bf16_t, WS_PROJ0 + PROJ_PAD);
          float* GBR = WSP(float, WS_GB);
          pg8::Gemm g{PROJ, (const bf16_t*)(wb + W_WG), NPROJ, 512, 256}; pg8::StaticOrder so; so.init(S, 1536, gridDim.x, (blockIdx.x + 160) % gridDim.x);
          EpiGate E{PROJ, P->conv_w + (size_t)l * 4 * 768, P->conv_b + l * 768, GBR + l * 768, GBR + (DEPTH + l) * 768, GBR + (2 * DEPTH + l) * 768, WSP(float, WS_A), WSP(float, WS_B)};
          pg8::gemm_phase<EpiGate, true>(lds, g, so, E); }
        XSYNC();
        { KParams P = kparams(); unsigned char* ws = P->ws; const int tid = otid(); const float* Ab = WSP(const float, WS_A); const float* Bb = WSP(const float, WS_B); float* CP = WSP(float, WS_CP); float* CH = WSP(float, WS_CH);
          for (int it = blockIdx.x; it < 256; it += gridDim.x) {
            if (tid < 384) {
              const int tc = it >> 1, c = 384 * (it & 1) + tid, t0 = 64 * tc;
              float Pp = 1.f, H = 0.f;
#pragma unroll
              for (int t = 0; t < 64; ++t) { const float a = Ab[(size_t)(t0 + t) * 768 + c], b = Bb[(size_t)(t0 + t) * 768 + c]; H = a * H + b; Pp *= a; }
              CP[tc * 768 + c] = Pp; CH[tc * 768 + c] = H;
            }
          } }
        { KParams P = kparams(); unsigned char* ws = P->ws; const int tid = otid(), lane = tid & 63;
          const float linit = 0.8f - 0.6f * expf(-0.3f * (float)l);
          const float s1 = wave_sum(P->lam_q1[l * 64 + lane] * P->lam_k1[l * 64 + lane]), s2 = wave_sum(P->lam_q2[l * 64 + lane] * P->lam_k2[l * 64 + lane]);
          AttnArgs a{WSP(const bf16_t, WS_PROJ0 + PROJ_PAD), WSP(const bf16_t, WS_Q), WSP(const bf16_t, WS_KV), WSP(bf16_t, WS_MIX), WSP(float, WS_STASH), WSP(float, WS_PARTO), WSP(float, WS_PARTML),
                     P->g_sub + l * 128, expf(s1) - expf(s2) + linit, 1.f - linit};
          unsigned* qctr = (unsigned*)(ws + WS_BAR) + XCD_BAR_WORDS + 64 * l;
          bool first = true;
#pragma unroll 1
          for (;;) {
              if (tid == 0) { const unsigned idx = first ? (unsigned)blockIdx.x : (unsigned)gridDim.x + xb_add(qctr, 1u);
                              bst[2] = (idx < (unsigned)N_ATT_UNITS) ? (unsigned)(int)P->order[idx] : 0xffffffffu; }
              first = false;
              __syncthreads();
              const int u = __builtin_amdgcn_readfirstlane((int)bst[2]);
              if (u < 0) break;
              attn_dispatch(lds, a, u);
          } }
        XSYNC();
        { KParams P = kparams(); unsigned char* ws = P->ws; const int tid = otid(); const float* Ab = WSP(const float, WS_A); const float* Bb = WSP(const float, WS_B); const float* CP = WSP(const float, WS_CP); const float* CH = WSP(const float, WS_CH);
          const bf16_t* PROJ = WSP(const bf16_t, WS_PROJ0 + PROJ_PAD); bf16_t* MIX = WSP(bf16_t, WS_MIX);
          for (int it = blockIdx.x; it < 256; it += gridDim.x) {
            if (tid < 384) {
              const int tc = it >> 1, c = 384 * (it & 1) + tid, t0 = 64 * tc;
              float H = 0.f;
#pragma unroll 64
              for (int j = 0; j < tc; ++j) H = CP[j * 768 + c] * H + CH[j * 768 + c];
#pragma unroll 1
              for (int tb = 0; tb < 64; tb += 16) {
                  float av[16], bv[16]; unsigned yv[16];
#pragma unroll
                  for (int t = 0; t < 16; ++t) { av[t] = Ab[(size_t)(t0 + tb + t) * 768 + c]; bv[t] = Bb[(size_t)(t0 + tb + t) * 768 + c]; yv[t] = PROJ[(size_t)(t0 + tb + t) * NPROJ + 768 + c]; }
                  __builtin_amdgcn_sched_barrier(0);
#pragma unroll
                  for (int t = 0; t < 16; ++t) { H = av[t] * H + bv[t]; MIX[(size_t)(t0 + tb + t) * DM + c] = (bf16_t)f2bf(H * gelu_tanh(bf2f(yv[t]))); }
              }
            }
          } }
        { KParams P = kparams(); unsigned char* ws = P->ws; const int tid = otid(), lane = tid & 63, wave = __builtin_amdgcn_readfirstlane(tid >> 6);
          const float linit = 0.8f - 0.6f * expf(-0.3f * (float)l);
          const float s1 = wave_sum(P->lam_q1[l * 64 + lane] * P->lam_k1[l * 64 + lane]), s2 = wave_sum(P->lam_q2[l * 64 + lane] * P->lam_k2[l * 64 + lane]);
          const float lam = expf(s1) - expf(s2) + linit, oml = 1.f - linit;
          const float* PO = WSP(const float, WS_PARTO); const float* PML = WSP(const float, WS_PARTML); bf16_t* MIX = WSP(bf16_t, WS_MIX);
          const f32x2 gs = *(const f32x2*)(P->g_sub + l * 128 + 2 * lane);
          const int NGW = gridDim.x * 8;
#pragma unroll 1
          for (int rr = blockIdx.x * 8 + wave; rr < 4096; rr += NGW) {
              f32x2 ml[28], po[28];
#pragma unroll
              for (int p = 0; p < 28; ++p) { ml[p] = *(const f32x2*)(PML + ((size_t)p * 4096 + rr) * 2); po[p] = *(const f32x2*)(PO + ((size_t)p * 4096 + rr) * 128 + 2 * lane); }
              bf16_t* mrow = MIX + (size_t)(4096 + rr) * DM;
#pragma unroll
              for (int hh = 0; hh < 4; ++hh) {
                  f32x2 om[2];
#pragma unroll
                  for (int m = 0; m < 2; ++m) { const int p0 = (hh * 2 + m) * 2;
                      const float M = fmaxf(ml[p0][0], ml[p0 + 1][0]), w0 = __builtin_amdgcn_exp2f((ml[p0][0] - M) * C_DIFF), w1 = __builtin_amdgcn_exp2f((ml[p0 + 1][0] - M) * C_DIFF);
                      const float inv = 1.f / (w0 * ml[p0][1] + w1 * ml[p0 + 1][1]);
                      om[m] = (po[p0] * w0 + po[p0 + 1] * w1) * inv; }
                  const f32x2 o = om[0] - om[1] * lam;
                  const float ss = wave_sum(o[0] * o[0] + o[1] * o[1]);
                  const float rs = oml / sqrtf(ss * (1.f / 128.f) + SUBLN_EPS);
                  ((unsigned*)(mrow + 768 + 128 * hh))[lane] = pk2(o[0] * rs * gs[0], o[1] * rs * gs[1]);
              }
#pragma unroll
              for (int hh = 0; hh < 6; ++hh) { const int p0 = (8 + hh) * 2;
                  const float M = fmaxf(ml[p0][0], ml[p0 + 1][0]), w0 = __builtin_amdgcn_exp2f((ml[p0][0] - M) * C_MLA), w1 = __builtin_amdgcn_exp2f((ml[p0 + 1][0] - M) * C_MLA);
                  const float inv = 1.f / (w0 * ml[p0][1] + w1 * ml[p0 + 1][1]);
                  const f32x2 o = (po[p0] * w0 + po[p0 + 1] * w1) * inv;
                  ((unsigned*)(mrow + 1280 + 128 * hh))[lane] = pk2(o[0], o[1]);
              }
          } }
        XSYNC();
        { KParams P = kparams(); unsigned char* ws = P->ws; unsigned char* wb = ws + WS_W + (size_t)l * LAYER_W;
          pg8::Gemm g{WSP(const bf16_t, WS_MIX), (const bf16_t*)(wb + W_WOUT), DM, DM, 0}; pg8::StaticOrder so; so.init(S, DM, gridDim.x, blockIdx.x);
          EpiResid E{(l == 0) ? P->x : WSP(const float, WS_X), WSP(float, WS_X)}; pg8::gemm_phase<EpiResid, false>(lds, g, so, E); }
        XSYNC();
        { KParams P = kparams(); unsigned char* ws = P->ws; const int tid = otid(), lane = tid & 63, wave = __builtin_amdgcn_readfirstlane(tid >> 6);
          norm_rows(WSP(const float, WS_X), P->g_ffn + l * DM, WSP(bf16_t, WS_HN), nullptr, blockIdx.x * 8 + wave, gridDim.x * 8, lane); }
        XSYNC();
        { KParams P = kparams(); unsigned char* ws = P->ws; unsigned char* wb = ws + WS_W + (size_t)l * LAYER_W;
          pg8::Gemm g{WSP(const bf16_t, WS_HN), (const bf16_t*)(wb + W_WGU), DM, DM, 0}; pg8::StaticOrder so; so.init(S, NGU, gridDim.x, blockIdx.x);
          EpiSwiGLU E{WSP(bf16_t, WS_ACT)}; pg8::gemm_phase<EpiSwiGLU, false>(lds, g, so, E); }
        XSYNC();
        { KParams P = kparams(); unsigned char* ws = P->ws; unsigned char* wb = ws + WS_W + (size_t)l * LAYER_W;
          pg8::Gemm g{WSP(const bf16_t, WS_ACT), (const bf16_t*)(wb + W_WDOWN), DFF, DFF, 0}; pg8::StaticOrder so; so.init(S, DM, gridDim.x, blockIdx.x);
          EpiResid E{WSP(const float, WS_X), WSP(float, WS_X)}; pg8::gemm_phase<EpiResid, false>(lds, g, so, E); }
        XSYNC();
    }
    { KParams P = kparams(); unsigned char* ws = P->ws; const int tid = otid(), lane = tid & 63, wave = __builtin_amdgcn_readfirstlane(tid >> 6);
      norm_rows(WSP(const float, WS_X), P->g_final, nullptr, P->out, blockIdx.x * 8 + wave, gridDim.x * 8, lane); }
}

extern "C" void kernel_launch(void* const* d_in, const int* in_sizes, int n_in, void* d_out, int out_size, void* d_ws, size_t ws_size, hipStream_t stream) {
    static int grid = 0;
    if (grid == 0) {
        if (n_in != 26 || ws_size < WS_END) { fprintf(stderr, "kernel_launch: unexpected n_in %d / ws_size %zu (need %zu)\n", n_in, ws_size, (size_t)WS_END); grid = -1; return; }
        int dev = 0, cus = 0, per_cu = 0;
        hipGetDevice(&dev); hipDeviceGetAttribute(&cus, hipDeviceAttributeMultiprocessorCount, dev);
        hipFuncSetAttribute((const void*)mega_fwd, hipFuncAttributeMaxDynamicSharedMemorySize, LDS_BYTES);
        hipOccupancyMaxActiveBlocksPerMultiprocessor(&per_cu, (const void*)mega_fwd, 512, LDS_BYTES);
        if (per_cu < 1) per_cu = 1;
        grid = cus * per_cu;
        (void)hipGetLastError();
    }
    if (grid < 0) return;
    if (hipMemsetAsync((char*)d_ws + WS_BAR, 0, (XCD_BAR_WORDS + 64 * DEPTH) * 4, stream) != hipSuccess) { fprintf(stderr, "memset failed\n"); return; }
    static short order_tab[N_ATT_UNITS];
    static bool sched_ok = false;
    if (!sched_ok) {
        int cost[N_ATT_UNITS], order[N_ATT_UNITS];
        for (int u = 0; u < N_ATT_UNITS; ++u) {
            int qb, wgt;
            if (u < 64) { qb = u >> 2; wgt = 48; } else if (u < 160) { qb = (u - 64) / 6; wgt = 40; } else if (u < 416) { qb = 16 + ((u - 160) >> 4); wgt = 12; } else { qb = 16 + ((u - 416) >> 1) / 6; wgt = 20; }
            cost[u] = wgt * (4 * qb + 4); order[u] = u;
        }
        for (int i = 1; i < N_ATT_UNITS; ++i) { const int u = order[i]; int j = i - 1; while (j >= 0 && (cost[order[j]] < cost[u])) { order[j + 1] = order[j]; --j; } order[j + 1] = u; }
        for (int i = 0; i < N_ATT_UNITS; ++i) order_tab[i] = (short)order[i];
        sched_ok = true;
    }
    Params p{};
    for (int i = 0; i < N_ATT_UNITS; ++i) p.order[i] = order_tab[i];
    p.x = (const float*)d_in[0]; p.pos = (const int*)d_in[1]; p.g_mix = (const float*)d_in[2]; p.w_in = (const float*)d_in[3]; p.conv_w = (const float*)d_in[4]; p.conv_b = (const float*)d_in[5];
    p.w_r = (const float*)d_in[6]; p.b_r = (const float*)d_in[7]; p.w_i = (const float*)d_in[8]; p.b_i = (const float*)d_in[9]; p.lru_lambda = (const float*)d_in[10];
    p.lam_q1 = (const float*)d_in[11]; p.lam_k1 = (const float*)d_in[12]; p.lam_q2 = (const float*)d_in[13]; p.lam_k2 = (const float*)d_in[14]; p.g_sub = (const float*)d_in[15];
    p.g_q_a = (const float*)d_in[16]; p.w_q_b = (const float*)d_in[17]; p.g_kv_a = (const float*)d_in[18]; p.w_kv_b = (const float*)d_in[19]; p.w_out = (const float*)d_in[20];
    p.g_ffn = (const float*)d_in[21]; p.w_gate = (const float*)d_in[22]; p.w_up = (const float*)d_in[23]; p.w_down = (const float*)d_in[24]; p.g_final = (const float*)d_in[25];
    p.out = (float*)d_out; p.ws = (unsigned char*)d_ws;
    void* args[] = {&p};
    hipError_t e = hipLaunchCooperativeKernel((const void*)mega_fwd, dim3(grid), dim3(512), args, LDS_BYTES, stream);
    if (e != hipSuccess) fprintf(stderr, "cooperative launch failed: %s (grid %d)\n", hipGetErrorString(e), grid);
}
```
